# Optimizing an MI355X kernel written in HIP

```python
import math
import jax, jax.numpy as jnp
from jax import lax
import numpy as np

D_MODEL = 2048
BATCH = 8
SEQ = 2048
DEPTH = 4
DEC_BATCH = 8
DEC_SEQ = 32
PAST_LEN = 2048

CHUNK = 64
N_META = 16
D_MIX = D_MODEL
D_A = D_MIX // 2
N_BLOCKS_A = 16
BS_A = D_A // N_BLOCKS_A
CONV_W = 4
RG_C = 8.0
N_HEADS_B = 8
DK = 64
DV = 2 * DK
D_B = N_HEADS_B * DV
QK_W = N_HEADS_B * 2 * DK
IN_COLS = 2 * D_A + 2 * QK_W + 2 * D_B
NUM_BUCKETS = 32
REL_MAX_DIST = 1024
QBLOCK = 128
EPS = 1e-6

kernel_name = "hymba_rglru_diffattn_stream_step"


def rms_norm(x, g):
    xf = x.astype(jnp.float32)
    y = xf * lax.rsqrt(jnp.mean(xf * xf, axis=-1, keepdims=True) + EPS)
    return (y * g.astype(jnp.float32)).astype(x.dtype)


def rel_bucket(rel):
    half = NUM_BUCKETS // 2
    max_exact = half // 2
    ret = jnp.where(rel > 0, half, 0).astype(jnp.int32)
    n = jnp.abs(rel).astype(jnp.int32)
    nf = jnp.maximum(n, 1).astype(jnp.float32)
    large = max_exact + (jnp.log(nf / max_exact) / math.log(REL_MAX_DIST / max_exact)
                         * (half - max_exact)).astype(jnp.int32)
    large = jnp.minimum(large, half - 1)
    return ret + jnp.where(n < max_exact, n, large)


def rel_bias_block(qpos, kpos, rel_bias):
    b = rel_bias.astype(jnp.float32)[rel_bucket(kpos[None, :] - qpos[:, None])]
    return jnp.transpose(b, (2, 0, 1))


def chunk_id(pos):
    return jnp.where(pos < N_META, -1, (pos - N_META) // CHUNK)


def diff_attend(q1, q2, k1, k2, v, bias, mask, lam):
    scale = DK ** -0.5
    l1 = jnp.einsum('bqhd,bkhd->bhqk', q1, k1).astype(jnp.float32) * scale + bias
    l2 = jnp.einsum('bqhd,bkhd->bhqk', q2, k2).astype(jnp.float32) * scale + bias
    if mask is not None:
        l1 = jnp.where(mask, l1, -jnp.inf)
        l2 = jnp.where(mask, l2, -jnp.inf)
    p = jax.nn.softmax(l1, axis=-1) - lam * jax.nn.softmax(l2, axis=-1)
    return jnp.einsum('bhqk,bkhd->bqhd', p.astype(v.dtype), v)


def diff_attn_prompt(q1, q2, k1, k2, v, rel_bias, lam):
    B, L = q1.shape[0], q1.shape[1]
    nblk = -(-L // QBLOCK)
    Lp = nblk * QBLOCK
    pad = ((0, 0), (0, Lp - L), (0, 0), (0, 0))
    q1p = jnp.pad(q1, pad)
    q2p = jnp.pad(q2, pad)
    kpos = jnp.arange(L)
    kchunk = chunk_id(kpos)

    def block(i):
        s = i * QBLOCK
        qpos = s + jnp.arange(QBLOCK)
        qb1 = lax.dynamic_slice_in_dim(q1p, s, QBLOCK, axis=1)
        qb2 = lax.dynamic_slice_in_dim(q2p, s, QBLOCK, axis=1)
        bias = rel_bias_block(qpos, kpos, rel_bias)
        mask = kchunk[None, :] <= chunk_id(qpos)[:, None]
        return diff_attend(qb1, qb2, k1, k2, v, bias, mask, lam)

    out = lax.map(block, jnp.arange(nblk))
    out = jnp.moveaxis(out, 0, 1).reshape(B, Lp, N_HEADS_B, DV)
    return out[:, :L]


def diff_attn_sample(q1, q2, k1_all, k2_all, v_all, rel_bias, lam):
    T = q1.shape[1]
    K = k1_all.shape[1]
    P = K - T
    kpos = jnp.arange(K)
    qpos = P + jnp.arange(T)
    bias = rel_bias_block(qpos, kpos, rel_bias)
    return diff_attend(q1, q2, k1_all, k2_all, v_all, bias, None, lam)


def lin_scan(a, b, h0):
    b = b.at[:, 0].add(a[:, 0] * h0)

    def comb(left, right):
        return (left[0] * right[0], right[0] * left[1] + right[1])

    _, h = lax.associative_scan(comb, (a, b), axis=1)
    return h


def rglru_branch(xa, conv_buf, h0, conv_w, conv_b, wr, br, wi, bi, lam_param):
    B, T = xa.shape[0], xa.shape[1]
    xp = jnp.concatenate([conv_buf.astype(xa.dtype), xa], axis=1)
    xc = conv_b
    for j in range(CONV_W):
        xc = xc + xp[:, j:j + T] * conv_w[j]
    new_buf = xp[:, -(CONV_W - 1):]
    xb = xc.reshape(B, T, N_BLOCKS_A, BS_A)
    r = jax.nn.sigmoid(jnp.einsum('btnc,ncd->btnd', xb, wr) + br).reshape(B, T, D_A)
    i = jax.nn.sigmoid(jnp.einsum('btnc,ncd->btnd', xb, wi) + bi).reshape(B, T, D_A)
    log_a = -RG_C * r.astype(jnp.float32) * jax.nn.softplus(-lam_param.astype(jnp.float32))
    a = jnp.exp(log_a)
    bterm = jnp.sqrt(-jnp.expm1(2.0 * log_a)) * (i * xc).astype(jnp.float32)
    h = lin_scan(a, bterm, h0.astype(jnp.float32))
    return h.astype(xa.dtype), new_buf, h[:, -1]


def layer_forward(x, conv_buf, h0, k_cache, v_cache, rel_bias, pre_g, post_g, w_in, conv_w, conv_b,
                  wr, br, wi, bi, rglru_lam, lq1, lk1, lq2, lk2, subln_g, w_out, lam_init, is_prompt):
    B, T = x.shape[0], x.shape[1]
    u = rms_norm(x, pre_g)
    proj = jnp.einsum('btd,dc->btc', u, w_in)
    splits = [D_A, 2 * D_A, 2 * D_A + QK_W, 2 * D_A + 2 * QK_W, 2 * D_A + 2 * QK_W + D_B]
    xa, ga, q, k, v, gb = jnp.split(proj, splits, axis=-1)
    ya, new_buf, h_last = rglru_branch(xa, conv_buf, h0, conv_w, conv_b, wr, br, wi, bi, rglru_lam)
    ya = ya * jax.nn.silu(ga)
    q = q.reshape(B, T, N_HEADS_B, 2, DK)
    k_rows = k.reshape(B, T, N_HEADS_B, 2 * DK)
    v_rows = v.reshape(B, T, N_HEADS_B, DV)
    lam = (jnp.exp(jnp.sum(lq1.astype(jnp.float32) * lk1.astype(jnp.float32)))
           - jnp.exp(jnp.sum(lq2.astype(jnp.float32) * lk2.astype(jnp.float32))) + lam_init)
    if is_prompt:
        o = diff_attn_prompt(q[..., 0, :], q[..., 1, :], k_rows[..., :DK], k_rows[..., DK:], v_rows,
                             rel_bias, lam)
    else:
        k_all = jnp.concatenate([k_cache.astype(k_rows.dtype), k_rows], axis=1)
        v_all = jnp.concatenate([v_cache.astype(v_rows.dtype), v_rows], axis=1)
        o = diff_attn_sample(q[..., 0, :], q[..., 1, :], k_all[..., :DK], k_all[..., DK:], v_all,
                             rel_bias, lam)
    o = rms_norm(o, subln_g) * (1.0 - lam_init)
    yb = o.reshape(B, T, D_B) * jax.nn.silu(gb)
    y = jnp.einsum('btc,cd->btd', jnp.concatenate([ya, yb], axis=-1), w_out)
    x = x + rms_norm(y, post_g)
    return x, k_rows, v_rows, new_buf, h_last


def setup_inputs(seed: int = 0) -> dict:
    key = jax.random.key(seed)
    ks = jax.random.split(key, 24)
    f32 = jnp.float32
    nrm = lambda k, shape, s: (jax.random.normal(k, shape, f32) * s)
    u = jax.random.uniform(ks[12], (DEPTH, D_A), f32, 0.9, 0.999)
    s = u ** (1.0 / RG_C)
    rglru_lam = jnp.log(s / (1.0 - s))
    return {
        "x_prompt": nrm(ks[0], (BATCH, SEQ, D_MODEL), 1.0),
        "x_sample": nrm(ks[1], (DEC_BATCH, DEC_SEQ, D_MODEL), 1.0),
        "cache_k": nrm(ks[2], (DEPTH, DEC_BATCH, PAST_LEN, N_HEADS_B, 2 * DK), 1.0),
        "cache_v": nrm(ks[3], (DEPTH, DEC_BATCH, PAST_LEN, N_HEADS_B, DV), 1.0),
        "state_conv": nrm(ks[4], (DEPTH, DEC_BATCH, CONV_W - 1, D_A), 1.0),
        "state_rglru": nrm(ks[5], (DEPTH, DEC_BATCH, D_A), 0.5),
        "meta": nrm(ks[6], (N_META, D_MODEL), 1.0),
        "rel_bias": nrm(ks[7], (NUM_BUCKETS, N_HEADS_B), 0.5),
        "pre_g": 1.0 + nrm(ks[8], (DEPTH, D_MODEL), 0.05),
        "post_g": 1.0 + nrm(ks[9], (DEPTH, D_MODEL), 0.05),
        "w_in": nrm(ks[10], (DEPTH, D_MODEL, IN_COLS), D_MODEL ** -0.5),
        "conv_w": nrm(ks[11], (DEPTH, CONV_W, D_A), CONV_W ** -0.5),
        "conv_b": nrm(ks[13], (DEPTH, D_A), 0.02),
        "gate_r_w": nrm(ks[14], (DEPTH, N_BLOCKS_A, BS_A, BS_A), BS_A ** -0.5),
        "gate_r_b": nrm(ks[15], (DEPTH, N_BLOCKS_A, BS_A), 0.02),
        "gate_i_w": nrm(ks[16], (DEPTH, N_BLOCKS_A, BS_A, BS_A), BS_A ** -0.5),
        "gate_i_b": nrm(ks[17], (DEPTH, N_BLOCKS_A, BS_A), 0.02),
        "rglru_lam": rglru_lam,
        "lam_q1": nrm(ks[18], (DEPTH, DK), 0.1),
        "lam_k1": nrm(ks[19], (DEPTH, DK), 0.1),
        "lam_q2": nrm(ks[20], (DEPTH, DK), 0.1),
        "lam_k2": nrm(ks[21], (DEPTH, DK), 0.1),
        "subln_g": 1.0 + nrm(ks[22], (DEPTH, DV), 0.05),
        "w_out": nrm(ks[23], (DEPTH, D_MIX, D_MODEL), D_MIX ** -0.5),
    }


def reference(x_prompt, x_sample, cache_k, cache_v, state_conv, state_rglru, meta, rel_bias,
              pre_g, post_g, w_in, conv_w, conv_b, gate_r_w, gate_r_b, gate_i_w, gate_i_b,
              rglru_lam, lam_q1, lam_k1, lam_q2, lam_k2, subln_g, w_out):
    B = x_prompt.shape[0]
    hp = jnp.concatenate([jnp.broadcast_to(meta.astype(x_prompt.dtype)[None], (B, N_META, D_MODEL)),
                          x_prompt], axis=1)
    hs = x_sample
    zero_buf = jnp.zeros((B, CONV_W - 1, D_A), x_prompt.dtype)
    zero_h = jnp.zeros((B, D_A), jnp.float32)
    kp_l, vp_l, cp_l, rp_l = [], [], [], []
    ks_l, vs_l, cs_l, rs_l = [], [], [], []
    for l in range(DEPTH):
        lam_init = 0.8 - 0.6 * math.exp(-0.3 * l)
        params = (rel_bias, pre_g[l], post_g[l], w_in[l], conv_w[l], conv_b[l], gate_r_w[l], gate_r_b[l],
                  gate_i_w[l], gate_i_b[l], rglru_lam[l], lam_q1[l], lam_k1[l], lam_q2[l], lam_k2[l],
                  subln_g[l], w_out[l], lam_init)
        hp, kp, vp, cp, rp = layer_forward(hp, zero_buf, zero_h, None, None, *params, True)
        hs, kk, vv, cs, rs = layer_forward(hs, state_conv[l], state_rglru[l], cache_k[l], cache_v[l],
                                           *params, False)
        kp_l.append(kp); vp_l.append(vp); cp_l.append(cp); rp_l.append(rp)
        ks_l.append(kk); vs_l.append(vv); cs_l.append(cs); rs_l.append(rs)
    y_prompt = hp[:, N_META:]
    y_sample = hs
    return (y_prompt, y_sample,
            jnp.stack(kp_l), jnp.stack(vp_l), jnp.stack(cp_l), jnp.stack(rp_l),
            jnp.stack(ks_l), jnp.stack(vs_l), jnp.stack(cs_l), jnp.stack(rs_l))
```

```cpp
#include <hip/hip_runtime.h>
#include <hip/hip_cooperative_groups.h>
#include <cstdio>
#include <cstdint>
namespace cg = cooperative_groups;
namespace pg8 {
#define PG8_LAS __attribute__((address_space(3)))
typedef unsigned short bf16_t;
typedef short bf16x8 __attribute__((ext_vector_type(8)));
typedef float f32x4 __attribute__((ext_vector_type(4)));
typedef unsigned u32x4 __attribute__((ext_vector_type(4)));
constexpr int BM = 256, BK = 64, HALF = 128, HTB = HALF * BK * 2  , STAGE_BYTES = 8 * HTB, NXCD = 8, WGM = 8;

__host__ __device__ __forceinline__ int lds_byte(int r, int c) { const int st = (r >> 4) * 2 + (c >> 5), rr = r & 15, cc = c & 31, ob = rr * 64 + cc * 2; return st * 1024 + (ob ^ (((ob >> 9) & 1) << 5)); }
__host__ __device__ __forceinline__ void stage_rc(int b, int& R, int& C) { const int st = b / 1024, sb = b % 1024, swz = sb ^ (((sb >> 9) & 1) << 5); R = (st >> 1) * 16 + swz / 64; C = (st & 1) * 32 + (swz % 64) / 2; }
__host__ __device__ __forceinline__ int perm32(int rho) { const int n = rho >> 4, i = rho & 15; return 8 * (i >> 2) + 4 * n + (i & 3); }

struct Unit { int pm, pn, k0; };
struct Gemm { const bf16_t* A; const bf16_t* Bt; int M, N, K, ld; };

struct StaticOrder {
    int nM, nN, nwg, G, c;
    __host__ __device__ void init(int M, int N, int G_, int c_) { nM = M / BM; nN = N / BM; nwg = nM * nN; G = G_; c = c_; }
    __host__ __device__ bool next(int i, Unit& u) const {
        const long L = (long)i * G + c; if (L >= nwg) return false;
        int wgid = (int)L; { const int q = nwg / NXCD, r = nwg % NXCD, xcd = wgid % NXCD, off = wgid / NXCD; wgid = (xcd < r ? xcd * (q + 1) : r * (q + 1) + (xcd - r) * q) + off; }
        const int nig = WGM * nN, gid = wgid / nig, fm = gid * WGM, gsz = (nM - fm) < WGM ? (nM - fm) : WGM;
        u.pm = fm + ((wgid % nig) % gsz); u.pn = (wgid % nig) / gsz; u.k0 = 0; return true;
    }
    __device__ __forceinline__ void a_ready(const Unit&) const {}
    __device__ __forceinline__ void done(const Unit&) const {}
};

__device__ __forceinline__ unsigned cvt_pk_bf16(float lo, float hi) { unsigned r; asm volatile("v_cvt_pk_bf16_f32 %0, %1, %2" : "=v"(r) : "v"(lo), "v"(hi)); return r; }

template <class Epi, class Sched, bool ALIGN_EPI = false, bool SP2 = false>
__device__ __forceinline__ void gemm_phase(PG8_LAS unsigned char* lds, const Gemm g, const Sched& S, const Epi& E) {
    int tid_ = threadIdx.x; asm volatile("" : "+v"(tid_)); const int tid = tid_, wid = __builtin_amdgcn_readfirstlane(tid >> 6), lane = tid & 63, wr = wid >> 2, wc = wid & 3, fr = lane & 15, fq = lane >> 4;
    const int K = g.ld, nt = g.K / BK;
    unsigned voffA[2], voffB[2];
#pragma unroll
    for (int i = 0; i < 2; ++i) { int R, C; stage_rc(tid * 16 + i * 8192, R, C); const int Rb = Epi::PERM ? ((R & ~31) + perm32(R & 31)) : R;
        voffA[i] = (unsigned)(R * K + C) * 2u; voffB[i] = (unsigned)(Rb * K + C) * 2u; }
    const size_t kstep = (size_t)(BK * 2);
    const size_t hstep = (size_t)HALF * K * 2;
    const size_t tstep = 2 * hstep;
    const unsigned ldsw = (unsigned)wid * 1024u;
    const int aoff = lds_byte(wr * 64 + fr, fq * 8), boff = lds_byte(wc * 32 + fr, fq * 8);
#define PG8_SA(b, h) (((b) * 2 + (h)) * HTB)
#define PG8_SB(b, h) ((4 + (b) * 2 + (h)) * HTB)
#define PG8_STAGE(bufoff, gbase, voff) do { _Pragma("unroll") for (int _i = 0; _i < 2; ++_i) \
        __builtin_amdgcn_global_load_lds((const unsigned*)((const char*)(gbase) + (voff)[_i]), (PG8_LAS unsigned*)(lds + (bufoff) + ldsw + _i * 8192), 16, 0, 0); } while (0)
#define PG8_LDA(dst, b, h) do { _Pragma("unroll") for (int m = 0; m < 4; ++m) _Pragma("unroll") for (int k = 0; k < 2; ++k) dst[m][k] = *(const PG8_LAS bf16x8*)(lds + PG8_SA(b, h) + aoff + m * 2048 + k * 1024); } while (0)
#define PG8_LDB(dst, b, h) do { _Pragma("unroll") for (int n = 0; n < 2; ++n) _Pragma("unroll") for (int k = 0; k < 2; ++k) dst[n][k] = *(const PG8_LAS bf16x8*)(lds + PG8_SB(b, h) + boff + n * 2048 + k * 1024); } while (0)
#define PG8_MMA(ai, bj, At, Bt) do { __builtin_amdgcn_s_setprio(1); _Pragma("unroll") for (int m = 0; m < 4; ++m) _Pragma("unroll") for (int n = 0; n < 2; ++n) _Pragma("unroll") for (int k = 0; k < 2; ++k) \
        acc[ai][bj][m][n] = __builtin_amdgcn_mfma_f32_16x16x32_bf16(Bt[n][k], At[m][k], acc[ai][bj][m][n], 0, 0, 0); __builtin_amdgcn_s_setprio(0); } while (0)
#define PG8_WAIT_V(n) asm volatile("s_waitcnt vmcnt(" #n ")" ::: "memory")
#define PG8_WAIT_L(n) asm volatile("s_waitcnt lgkmcnt(" #n ")" ::: "memory")
#define PG8_BAR __builtin_amdgcn_s_barrier()
#define PG8_SCHED __builtin_amdgcn_sched_barrier(0)
    Unit cur, nxt; int ui = 0;
    if (!S.next(0, cur)) return;
    f32x4 acc[2][2][4][2];
#pragma unroll
    for (int a = 0; a < 2; ++a)
#pragma unroll
        for (int b = 0; b < 2; ++b)
#pragma unroll
            for (int m = 0; m < 4; ++m)
#pragma unroll
                for (int n = 0; n < 2; ++n) acc[a][b][m][n] = (f32x4){0.f, 0.f, 0.f, 0.f};
    bf16x8 At[4][2], B0[2][2], B1[2][2];
    const char* cA = (const char*)g.A + (size_t)cur.pm * tstep + (size_t)cur.k0 * 2; const char* cB = (const char*)g.Bt + (size_t)cur.pn * tstep + (size_t)cur.k0 * 2;
    S.a_ready(cur);
    if constexpr (SP2) {
        PG8_STAGE(PG8_SB(0, 0), cB, voffB); PG8_STAGE(PG8_SB(0, 1), cB + hstep, voffB); PG8_STAGE(PG8_SA(0, 0), cA, voffA); PG8_STAGE(PG8_SA(0, 1), cA + hstep, voffA);
        if (wr == 1) PG8_BAR;
        PG8_WAIT_V(2); PG8_BAR;
        PG8_STAGE(PG8_SB(1, 0), cB + kstep, voffB); PG8_STAGE(PG8_SA(1, 0), cA + kstep, voffA); PG8_STAGE(PG8_SB(1, 1), cB + hstep + kstep, voffB);
        PG8_WAIT_V(6); PG8_BAR;
    } else {
        PG8_STAGE(PG8_SB(0, 0), cB, voffB); PG8_STAGE(PG8_SA(0, 0), cA, voffA); PG8_STAGE(PG8_SB(0, 1), cB + hstep, voffB); PG8_STAGE(PG8_SA(0, 1), cA + hstep, voffA);
        if (wr == 1) PG8_BAR;
        PG8_WAIT_V(4); PG8_BAR;
        PG8_STAGE(PG8_SB(1, 0), cB + kstep, voffB); PG8_STAGE(PG8_SA(1, 0), cA + kstep, voffA); PG8_STAGE(PG8_SB(1, 1), cB + hstep + kstep, voffB);
        PG8_WAIT_V(6); PG8_BAR;
    }
    for (;;) {
        const bool has_next = S.next(ui + 1, nxt);
        const char* nA = has_next ? (const char*)g.A + (size_t)nxt.pm * tstep + (size_t)nxt.k0 * 2 : cA; const char* nB = has_next ? (const char*)g.Bt + (size_t)nxt.pn * tstep + (size_t)nxt.k0 * 2 : cB;
        for (int t = 0; t < nt; t += 2) {
            const bool last = (t == nt - 2);
            const char* a1 = cA + (size_t)(t + 1) * kstep;
            const char* a2 = last ? nA : cA + (size_t)(t + 2) * kstep; const char* b2 = last ? nB : cB + (size_t)(t + 2) * kstep;
            const char* a3 = a2 + kstep; const char* b3 = b2 + kstep;
            if (last && has_next) S.a_ready(nxt);
            if constexpr (SP2) {
            PG8_LDB(B0, 0, 0); PG8_LDB(B1, 0, 1); PG8_SCHED; PG8_LDA(At, 0, 0); PG8_STAGE(PG8_SA(1, 1), a1 + hstep, voffA);
            PG8_WAIT_V(8); PG8_WAIT_L(0); PG8_BAR; PG8_MMA(0, 0, At, B0); PG8_MMA(0, 1, At, B1); PG8_BAR; PG8_SCHED;
            PG8_LDA(At, 0, 1); PG8_STAGE(PG8_SB(0, 0), b2, voffB); PG8_STAGE(PG8_SB(0, 1), b2 + hstep, voffB); PG8_STAGE(PG8_SA(0, 0), a2, voffA);
            PG8_WAIT_V(8); PG8_WAIT_L(0); PG8_BAR; PG8_MMA(1, 0, At, B0); PG8_MMA(1, 1, At, B1); PG8_BAR; PG8_SCHED;
            PG8_LDB(B0, 1, 0); PG8_LDB(B1, 1, 1); PG8_SCHED; PG8_LDA(At, 1, 0); PG8_STAGE(PG8_SA(0, 1), a2 + hstep, voffA);
            PG8_WAIT_V(8); PG8_WAIT_L(0); PG8_BAR; PG8_MMA(0, 0, At, B0); PG8_MMA(0, 1, At, B1); PG8_BAR; PG8_SCHED;
            PG8_LDA(At, 1, 1); PG8_STAGE(PG8_SB(1, 0), b3, voffB); PG8_STAGE(PG8_SB(1, 1), b3 + hstep, voffB); PG8_STAGE(PG8_SA(1, 0), a3, voffA);
            PG8_WAIT_V(8); PG8_WAIT_L(0); PG8_BAR; PG8_MMA(1, 0, At, B0); PG8_MMA(1, 1, At, B1); PG8_BAR; PG8_SCHED;
            } else {
            PG8_LDB(B0, 0, 0); PG8_SCHED; PG8_LDA(At, 0, 0); PG8_STAGE(PG8_SA(1, 1), a1 + hstep, voffA);
            PG8_WAIT_L(8); PG8_BAR; PG8_WAIT_L(0); PG8_MMA(0, 0, At, B0); PG8_BAR; PG8_SCHED;
            PG8_LDB(B1, 0, 1); PG8_STAGE(PG8_SB(0, 0), b2, voffB);
            PG8_BAR; PG8_WAIT_L(0); PG8_MMA(0, 1, At, B1); PG8_BAR;
            PG8_LDA(At, 0, 1); PG8_STAGE(PG8_SA(0, 0), a2, voffA);
            PG8_BAR; PG8_WAIT_L(0); PG8_MMA(1, 0, At, B0); PG8_BAR; PG8_SCHED;
            PG8_STAGE(PG8_SB(0, 1), b2 + hstep, voffB);
            PG8_WAIT_V(6); PG8_BAR; PG8_MMA(1, 1, At, B1); PG8_BAR;
            PG8_LDB(B0, 1, 0); PG8_SCHED; PG8_LDA(At, 1, 0); PG8_STAGE(PG8_SA(0, 1), a2 + hstep, voffA);
            PG8_WAIT_L(8); PG8_BAR; PG8_WAIT_L(0); PG8_MMA(0, 0, At, B0); PG8_BAR; PG8_SCHED;
            PG8_LDB(B1, 1, 1); PG8_STAGE(PG8_SB(1, 0), b3, voffB);
            PG8_BAR; PG8_WAIT_L(0); PG8_MMA(0, 1, At, B1); PG8_BAR;
            PG8_LDA(At, 1, 1); PG8_STAGE(PG8_SA(1, 0), a3, voffA);
            PG8_BAR; PG8_WAIT_L(0); PG8_MMA(1, 0, At, B0); PG8_BAR; PG8_SCHED;
            PG8_STAGE(PG8_SB(1, 1), b3 + hstep, voffB);
            PG8_WAIT_V(6); PG8_BAR; PG8_MMA(1, 1, At, B1); PG8_BAR;
            }
        }
        if constexpr (ALIGN_EPI) { if (wr == 0) PG8_BAR; }
        if constexpr (!Epi::AFTER_DRAIN) { E(acc, cur, wr, wc, fr, fq); S.done(cur); }
        if (!has_next) break;
#pragma unroll
        for (int a = 0; a < 2; ++a)
#pragma unroll
            for (int b = 0; b < 2; ++b)
#pragma unroll
                for (int m = 0; m < 4; ++m)
#pragma unroll
                    for (int n = 0; n < 2; ++n) acc[a][b][m][n] = (f32x4){0.f, 0.f, 0.f, 0.f};
        cur = nxt; cA = nA; cB = nB; ++ui;
        if constexpr (ALIGN_EPI) { if (wr == 1) PG8_BAR; }
    }
    PG8_WAIT_V(0);
    if constexpr (!ALIGN_EPI) { if (wr == 0) PG8_BAR; }
    PG8_BAR;
    if constexpr (Epi::AFTER_DRAIN) { E.fused(acc, cur, wr, wc, fr, fq, lds, wid, lane); S.done(cur); }
#undef PG8_SA
#undef PG8_SB
#undef PG8_STAGE
#undef PG8_LDA
#undef PG8_LDB
#undef PG8_MMA
#undef PG8_WAIT_V
#undef PG8_WAIT_L
#undef PG8_BAR
#undef PG8_SCHED
}
}

#ifndef DUP_P0
#define DUP_P0 0
#endif
#ifndef DUP_P2
#define DUP_P2 0
#endif
#ifndef DUP_G1
#define DUP_G1 0
#endif
#ifndef DUP_RG
#define DUP_RG 0
#endif
#ifndef DUP_AT
#define DUP_AT 0
#endif
#ifndef DUP_SYNC
#define DUP_SYNC 0
#endif
#ifndef DUP_P4
#define DUP_P4 0
#endif
#ifndef DUP_LOOP
#define DUP_LOOP 0
#endif
#ifndef DUP_EXP
#define DUP_EXP 0
#endif
#ifndef DUP_QK
#define DUP_QK 0
#endif
#ifndef DUP_G2
#define DUP_G2 0
#endif
#define LAS __attribute__((address_space(3)))
typedef unsigned short bf16;
typedef short bf16x8 __attribute__((ext_vector_type(8)));
typedef short s16x4 __attribute__((ext_vector_type(4)));
typedef float f32x4 __attribute__((ext_vector_type(4)));
typedef unsigned u32x4 __attribute__((ext_vector_type(4)));
typedef unsigned u32x2 __attribute__((ext_vector_type(2)));

constexpr int D_MODEL = 2048, NBATCH = 8, SEQ = 2048, DEPTH = 4, DEC_T = 32, PAST = 2048;
constexpr int NMETA = 16, LP = NMETA + SEQ, MP = NBATCH * LP, MS = NBATCH * DEC_T, MTOT = MP + MS, MPAD = 16896;
constexpr int D_A = 1024, NH = 8, IN_COLS = 6144;
constexpr int C_XA = 0, C_GA = 1024, C_Q = 2048, C_K = 3072, C_V = 4096, C_GB = 5120;
constexpr float EPS = 1e-6f;
constexpr float LOG2E = 1.4426950408889634f;
constexpr int BT_N = 2176, BT_OFF = 2080, BT_LDS = 2304;

constexpr size_t O_YP = 0, O_YS = O_YP + (size_t)NBATCH * SEQ * D_MODEL, O_KP = O_YS + (size_t)MS * D_MODEL,
                 O_VP = O_KP + (size_t)DEPTH * MP * 1024, O_CP = O_VP + (size_t)DEPTH * MP * 1024, O_RP = O_CP + (size_t)DEPTH * NBATCH * 3 * D_A,
                 O_KS = O_RP + (size_t)DEPTH * NBATCH * D_A, O_VS = O_KS + (size_t)DEPTH * MS * 1024, O_CS = O_VS + (size_t)DEPTH * MS * 1024,
                 O_RS = O_CS + (size_t)DEPTH * NBATCH * 3 * D_A, O_END = O_RS + (size_t)DEPTH * NBATCH * D_A;

constexpr size_t MiB = 1u << 20;
constexpr size_t WS_CTL = 0, CTL_BYTES = 65536, WS_BAR = 16384, WS_LAM = 65536, WS_BT = 69632;
constexpr size_t WS_WIN = 1 * MiB, WS_WOUT = 97 * MiB, WS_X = 129 * MiB, WS_U = 261 * MiB, WS_PROJ = 327 * MiB, WS_YAB = 525 * MiB, WS_Y = 591 * MiB, WS_END = 723 * MiB;
static_assert(WS_WIN + (size_t)DEPTH * IN_COLS * D_MODEL * 2 <= WS_WOUT && WS_WOUT + (size_t)DEPTH * D_MODEL * D_MODEL * 2 <= WS_X && WS_X + (size_t)MPAD * D_MODEL * 4 <= WS_U &&
              WS_U + (size_t)MPAD * D_MODEL * 2 <= WS_PROJ && WS_PROJ + (size_t)MPAD * IN_COLS * 2 <= WS_YAB && WS_YAB + (size_t)MPAD * D_MODEL * 2 <= WS_Y && WS_Y + (size_t)MPAD * D_MODEL * 4 <= WS_END, "ws map");

constexpr size_t WS_PART = WS_Y + 66 * MiB;
static_assert(WS_PART + (size_t)16 * 512 * 2048 * 4 <= WS_END && (size_t)4 * 512 * 6144 * 4 <= (size_t)64 * MiB, "ws map 2");
constexpr int LDS_BYTES = 135168;
constexpr int LDS_SLOT = 131072;
constexpr int LDS_PARAM = 131072 + 64;
constexpr int NTHREADS = 512;

struct Params {
    const float *x_prompt, *x_sample, *cache_k, *cache_v, *state_conv, *state_rglru, *meta, *rel_bias, *pre_g, *post_g, *w_in, *conv_w, *conv_b,
        *gate_r_w, *gate_r_b, *gate_i_w, *gate_i_b, *rglru_lam, *lam_q1, *lam_k1, *lam_q2, *lam_k2, *subln_g, *w_out;
    float* out; unsigned char* ws;
};
__device__ __forceinline__ const float* ldp(const unsigned char* lds, int off) {
    const LAS unsigned* q = (const LAS unsigned*)(lds + LDS_PARAM + off);
    const unsigned lo = __builtin_amdgcn_readfirstlane(q[0]), hi = __builtin_amdgcn_readfirstlane(q[1]);
    return (const float*)(const __attribute__((address_space(1))) float*)(((unsigned long long)hi << 32) | (unsigned long long)lo);
}
static_assert(offsetof(Params, ws) == 200 && sizeof(Params) == 208, "Params layout");
#define PP(name) ldp(lds, (int)offsetof(Params, name))
#define P_OUT ((float*)ldp(lds, (int)offsetof(Params, out)))
#define P_WS ((unsigned char*)ldp(lds, (int)offsetof(Params, ws)))

__device__ __forceinline__ unsigned f2bf(float f) { unsigned u = __float_as_uint(f); return (u + 0x7fffu + ((u >> 16) & 1u)) >> 16; }
__device__ __forceinline__ unsigned pk2(float lo, float hi) { unsigned r; asm("v_cvt_pk_bf16_f32 %0, %1, %2" : "=v"(r) : "v"(lo), "v"(hi)); return r; }
__device__ __forceinline__ float bflo(unsigned u) { return __uint_as_float(u << 16); }
__device__ __forceinline__ float bfhi(unsigned u) { return __uint_as_float(u & 0xffff0000u); }
__device__ __forceinline__ float wave_sum(float v) {
#pragma unroll
    for (int o = 1; o < 64; o <<= 1) v += __shfl_xor(v, o);
    return v;
}
__device__ __forceinline__ float sigmoidf_(float x) { return __builtin_amdgcn_rcpf(1.f + __expf(-x)); }
__device__ __forceinline__ float siluf_(float x) { return x * __builtin_amdgcn_rcpf(1.f + __expf(-x)); }
__device__ __forceinline__ int opaque_tid() { int t = threadIdx.x; asm volatile("" : "+v"(t)); return t; }
#define LDS_BARRIER() asm volatile("s_waitcnt lgkmcnt(0)\n\ts_barrier" ::: "memory")
#define MFMA16(a, b, c) __builtin_amdgcn_mfma_f32_16x16x32_bf16((a), (b), (c), 0, 0, 0)
typedef short v4i16_t __attribute__((ext_vector_type(4)));
__device__ __forceinline__ s16x4 vtr(const unsigned char* p) { return __builtin_bit_cast(s16x4, __builtin_amdgcn_ds_read_tr16_b64_v4i16((LAS v4i16_t*)p)); }

struct EpiProj {
    static constexpr bool PERM = true, AFTER_DRAIN = false;
    bf16* P; float *kp, *vp, *ks, *vs;
    __device__ __forceinline__ void operator()(const f32x4 (&acc)[2][2][4][2], const pg8::Unit& u, int wr, int wc, int fr, int fq) const {
        const int row0 = u.pm * 256 + wr * 64 + fr, col0 = u.pn * 256 + wc * 32 + 8 * fq;
        const int kind = (u.pn >= 12 && u.pn < 16) ? 1 : ((u.pn >= 16 && u.pn < 20) ? 2 : 0);
#pragma unroll
        for (int ai = 0; ai < 2; ++ai)
#pragma unroll
            for (int m = 0; m < 4; ++m) {
                const int row = row0 + ai * 128 + m * 16;
                bf16* rowp = P + (size_t)row * IN_COLS + col0;
                float* fo = nullptr;
                if (kind != 0 && row < MTOT) {
                    if (kind == 1) fo = (row < MP ? kp + (size_t)row * 1024 : ks + (size_t)(row - MP) * 1024) + (col0 - C_K);
                    else           fo = (row < MP ? vp + (size_t)row * 1024 : vs + (size_t)(row - MP) * 1024) + (col0 - C_V);
                }
#pragma unroll
                for (int bj = 0; bj < 2; ++bj) {
                    const f32x4 v0 = acc[ai][bj][m][0], v1 = acc[ai][bj][m][1];
                    u32x4 wv; wv.x = pk2(v0[0], v0[1]); wv.y = pk2(v0[2], v0[3]); wv.z = pk2(v1[0], v1[1]); wv.w = pk2(v1[2], v1[3]);
                    *(u32x4*)(rowp + bj * 128) = wv;
                    if (fo) { *(f32x4*)(fo + bj * 128) = v0; *(f32x4*)(fo + bj * 128 + 4) = v1; }
                }
            }
    }
};
struct EpiY16 {
    static constexpr bool PERM = true, AFTER_DRAIN = false;
    bf16* Y;
    __device__ __forceinline__ void operator()(const f32x4 (&acc)[2][2][4][2], const pg8::Unit& u, int wr, int wc, int fr, int fq) const {
        const int row0 = u.pm * 256 + wr * 64 + fr, col0 = u.pn * 256 + wc * 32 + 8 * fq;
#pragma unroll
        for (int ai = 0; ai < 2; ++ai)
#pragma unroll
            for (int m = 0; m < 4; ++m) {
                bf16* rowp = Y + (size_t)(row0 + ai * 128 + m * 16) * D_MODEL + col0;
#pragma unroll
                for (int bj = 0; bj < 2; ++bj) { const f32x4 v0 = acc[ai][bj][m][0], v1 = acc[ai][bj][m][1];
                    u32x4 wv; wv.x = pk2(v0[0], v0[1]); wv.y = pk2(v0[2], v0[3]); wv.z = pk2(v1[0], v1[1]); wv.w = pk2(v1[2], v1[3]);
                    *(u32x4*)(rowp + bj * 128) = wv; }
            }
    }
};
constexpr int TAIL_ROW0 = 16384, TAIL_ROWS = 512, TAIL_KP = 16, TAIL_K = D_MODEL / TAIL_KP;
struct TailOrder {
    int G, c;
    __device__ __forceinline__ bool next(int i, pg8::Unit& u) const { const int L = i * G + c; if (L >= 16 * TAIL_KP) return false;
        const int tile = L / TAIL_KP, kp = L % TAIL_KP; u.pm = TAIL_ROW0 / 256 + (tile >> 3); u.pn = tile & 7; u.k0 = kp * TAIL_K; return true; }
    __device__ __forceinline__ void a_ready(const pg8::Unit&) const {}
    __device__ __forceinline__ void done(const pg8::Unit&) const {}
};
struct EpiPart {
    static constexpr bool PERM = true, AFTER_DRAIN = false;
    float* PART;
    __device__ __forceinline__ void operator()(const f32x4 (&acc)[2][2][4][2], const pg8::Unit& u, int wr, int wc, int fr, int fq) const {
        const int row0 = u.pm * 256 - TAIL_ROW0 + wr * 64 + fr, col0 = u.pn * 256 + wc * 32 + 8 * fq;
        float* base = PART + (size_t)(u.k0 / TAIL_K) * TAIL_ROWS * D_MODEL;
#pragma unroll
        for (int ai = 0; ai < 2; ++ai)
#pragma unroll
            for (int m = 0; m < 4; ++m) {
                float* rowp = base + (size_t)(row0 + ai * 128 + m * 16) * D_MODEL + col0;
#pragma unroll
                for (int bj = 0; bj < 2; ++bj) { *(f32x4*)(rowp + bj * 128) = acc[ai][bj][m][0]; *(f32x4*)(rowp + bj * 128 + 4) = acc[ai][bj][m][1]; }
            }
    }
};
constexpr int T1_KP = 4, T1_K = D_MODEL / T1_KP;
struct TailWhole {
    int G, c;
    __device__ __forceinline__ bool next(int i, pg8::Unit& u) const { const int L = i * G + c; if (L >= 48) return false; u.pm = TAIL_ROW0 / 256 + L / 24; u.pn = L % 24; u.k0 = 0; return true; }
    __device__ __forceinline__ void a_ready(const pg8::Unit&) const {}
    __device__ __forceinline__ void done(const pg8::Unit&) const {}
};
struct Tail1Order {
    int G, c;
    __device__ __forceinline__ bool next(int i, pg8::Unit& u) const { const int L = i * G + c; if (L >= 48 * T1_KP) return false;
        const int tile = L / T1_KP, kp = L % T1_KP; u.pm = TAIL_ROW0 / 256 + tile / 24; u.pn = tile % 24; u.k0 = kp * T1_K; return true; }
    __device__ __forceinline__ void a_ready(const pg8::Unit&) const {}
    __device__ __forceinline__ void done(const pg8::Unit&) const {}
};
struct EpiPart1 {
    static constexpr bool PERM = true, AFTER_DRAIN = false;
    float* PART;
    __device__ __forceinline__ void operator()(const f32x4 (&acc)[2][2][4][2], const pg8::Unit& u, int wr, int wc, int fr, int fq) const {
        const int row0 = u.pm * 256 - TAIL_ROW0 + wr * 64 + fr, col0 = u.pn * 256 + wc * 32 + 8 * fq;
        float* base = PART + (size_t)(u.k0 / T1_K) * TAIL_ROWS * IN_COLS;
#pragma unroll
        for (int ai = 0; ai < 2; ++ai)
#pragma unroll
            for (int m = 0; m < 4; ++m) {
                float* rowp = base + (size_t)(row0 + ai * 128 + m * 16) * IN_COLS + col0;
#pragma unroll
                for (int bj = 0; bj < 2; ++bj) { *(f32x4*)(rowp + bj * 128) = acc[ai][bj][m][0]; *(f32x4*)(rowp + bj * 128 + 4) = acc[ai][bj][m][1]; }
            }
    }
};
__device__ __forceinline__ void p1_tail_reduce(unsigned char* lds, int l) {
    const int tid = opaque_tid();
    const float* PART = (const float*)(P_WS + WS_PART); bf16* PROJ = (bf16*)(P_WS + WS_PROJ);
    float* kp = P_OUT + O_KP + (size_t)l * MP * 1024; float* vp = P_OUT + O_VP + (size_t)l * MP * 1024;
    float* ks = P_OUT + O_KS + (size_t)l * MS * 1024; float* vs = P_OUT + O_VS + (size_t)l * MS * 1024;
    constexpr int NIT = (MTOT - TAIL_ROW0) * (IN_COLS / 8);
    for (int it = blockIdx.x * NTHREADS + tid; it < NIT; it += gridDim.x * NTHREADS) {
        const int rl = it / (IN_COLS / 8), c = (it % (IN_COLS / 8)) * 8, row = TAIL_ROW0 + rl;
        const float* p0 = PART + (size_t)rl * IN_COLS + c;
        f32x4 a[T1_KP], b[T1_KP];
#pragma unroll
        for (int k = 0; k < T1_KP; ++k) { a[k] = *(const f32x4*)(p0 + (size_t)k * TAIL_ROWS * IN_COLS); b[k] = *(const f32x4*)(p0 + (size_t)k * TAIL_ROWS * IN_COLS + 4); }
        const f32x4 v0 = (a[0] + a[1]) + (a[2] + a[3]), v1 = (b[0] + b[1]) + (b[2] + b[3]);
        u32x4 wv; wv.x = pk2(v0[0], v0[1]); wv.y = pk2(v0[2], v0[3]); wv.z = pk2(v1[0], v1[1]); wv.w = pk2(v1[2], v1[3]);
        *(u32x4*)(PROJ + (size_t)row * IN_COLS + c) = wv;
        if (c >= C_K && c < C_GB) {
            float* fo = (c < C_V) ? ((row < MP ? kp + (size_t)row * 1024 : ks + (size_t)(row - MP) * 1024) + (c - C_K))
                                  : ((row < MP ? vp + (size_t)row * 1024 : vs + (size_t)(row - MP) * 1024) + (c - C_V));
            *(f32x4*)fo = v0; *(f32x4*)(fo + 4) = v1;
        }
    }
}
struct EpiF32 {
    static constexpr bool PERM = true, AFTER_DRAIN = false;
    float* Y;
    __device__ __forceinline__ void operator()(const f32x4 (&acc)[2][2][4][2], const pg8::Unit& u, int wr, int wc, int fr, int fq) const {
        const int row0 = u.pm * 256 + wr * 64 + fr, col0 = u.pn * 256 + wc * 32 + 8 * fq;
#pragma unroll
        for (int ai = 0; ai < 2; ++ai)
#pragma unroll
            for (int m = 0; m < 4; ++m) {
                float* rowp = Y + (size_t)(row0 + ai * 128 + m * 16) * D_MODEL + col0;
#pragma unroll
                for (int bj = 0; bj < 2; ++bj) { *(f32x4*)(rowp + bj * 128) = acc[ai][bj][m][0]; *(f32x4*)(rowp + bj * 128 + 4) = acc[ai][bj][m][1]; }
            }
    }
};

__device__ __forceinline__ void p0_transpose_item(const float* W, int K, int N, bf16* WT, float* scr, int item, int lane) {
    const int nblk = N / 32, kb = item / nblk, nb = item % nblk, k0 = 64 * kb, n0 = 32 * nb;
#pragma unroll 8
    for (int i = 0; i < 32; ++i) { const int kk = 2 * i + (lane >> 5); scr[kk * 33 + (lane & 31)] = W[(size_t)(k0 + kk) * N + n0 + (lane & 31)]; }
    asm volatile("s_waitcnt lgkmcnt(0)" ::: "memory");
    const int c = lane & 7;
#pragma unroll
    for (int j = 0; j < 4; ++j) { const int n = (lane >> 3) + 8 * j; const float* s = scr + (8 * c) * 33 + n;
        u32x4 o; o.x = pk2(s[0 * 33], s[1 * 33]); o.y = pk2(s[2 * 33], s[3 * 33]); o.z = pk2(s[4 * 33], s[5 * 33]); o.w = pk2(s[6 * 33], s[7 * 33]);
        *(u32x4*)(WT + (size_t)(n0 + n) * K + k0 + 8 * c) = o; }
    asm volatile("s_waitcnt lgkmcnt(0)" ::: "memory");
}

__device__ __forceinline__ int rel_bucket(int rel) {
    const int n = rel < 0 ? -rel : rel;
    int ret = rel > 0 ? 16 : 0;
    if (n < 8) return ret + n;
    const float nf = (float)n;
    int large = 8 + (int)(logf(nf / 8.0f) / 4.852030263919617f * 8.0f);
    large = large < 15 ? large : 15;
    return ret + large;
}

__device__ __forceinline__ void norm_to_u(const f32x4 (&v)[8], const float* g, bf16* urow, int lane) {
    float ss = 0.f;
#pragma unroll
    for (int j = 0; j < 8; ++j) ss += (v[j][0] * v[j][0] + v[j][1] * v[j][1]) + (v[j][2] * v[j][2] + v[j][3] * v[j][3]);
    const float rs = rsqrtf(wave_sum(ss) * (1.f / D_MODEL) + EPS);
#pragma unroll
    for (int j = 0; j < 8; ++j) {
        const f32x4 gg = *(const f32x4*)(g + 4 * lane + 256 * j);
        u32x2 o; o.x = pk2(v[j][0] * rs * gg[0], v[j][1] * rs * gg[1]); o.y = pk2(v[j][2] * rs * gg[2], v[j][3] * rs * gg[3]);
        *(u32x2*)(urow + 4 * lane + 256 * j) = o;
    }
}

__device__ __forceinline__ void p0_prologue(unsigned char* lds) {
    const int tid = opaque_tid(), lane = tid & 63, wave = tid >> 6;
    const int gw = blockIdx.x * 8 + wave, NGW = gridDim.x * 8;
    float* scr = (float*)(lds + wave * 16384);
    bf16* WinT = (bf16*)(P_WS + WS_WIN); bf16* WoutT = (bf16*)(P_WS + WS_WOUT);
    constexpr int I_IN = (D_MODEL / 64) * (IN_COLS / 32), I_OUT = (D_MODEL / 64) * (D_MODEL / 32);
    for (int it = gw; it < DEPTH * (I_IN + I_OUT); it += NGW) {
        if (it < DEPTH * I_IN) { const int l = it / I_IN, r = it % I_IN;
            p0_transpose_item(PP(w_in) + (size_t)l * D_MODEL * IN_COLS, D_MODEL, IN_COLS, WinT + (size_t)l * IN_COLS * D_MODEL, scr, r, lane); }
        else { const int it2 = it - DEPTH * I_IN, l = it2 / I_OUT, r = it2 % I_OUT;
            p0_transpose_item(PP(w_out) + (size_t)l * D_MODEL * D_MODEL, D_MODEL, D_MODEL, WoutT + (size_t)l * D_MODEL * D_MODEL, scr, r, lane); }
    }
    __syncthreads();
    *(f32x4*)(lds + 16 * tid) = *(const f32x4*)(PP(pre_g) + 4 * tid);
    __syncthreads();
    bf16* U = (bf16*)(P_WS + WS_U); bf16* YAB = (bf16*)(P_WS + WS_YAB);
    for (int r = gw; r < MPAD; r += NGW) {
        if (r >= MTOT) {
#pragma unroll
            for (int j = 0; j < 8; ++j) { *(u32x2*)(U + (size_t)r * D_MODEL + 4 * lane + 256 * j) = (u32x2){0u, 0u}; *(u32x2*)(YAB + (size_t)r * D_MODEL + 4 * lane + 256 * j) = (u32x2){0u, 0u}; }
            continue;
        }
        const float* src;
        if (r < MP) { const int b = r / LP, pos = r % LP; src = pos < NMETA ? PP(meta) + (size_t)pos * D_MODEL : PP(x_prompt) + ((size_t)b * SEQ + (pos - NMETA)) * D_MODEL; }
        else src = PP(x_sample) + (size_t)(r - MP) * D_MODEL;
        f32x4 v[8];
#pragma unroll
        for (int j = 0; j < 8; ++j) v[j] = *(const f32x4*)(src + 4 * lane + 256 * j);
        norm_to_u(v, (const float*)lds, U + (size_t)r * D_MODEL, lane);
    }
    float* BT = (float*)(P_WS + WS_BT);
    for (int i = blockIdx.x * NTHREADS + tid; i < NH * BT_N; i += gridDim.x * NTHREADS) {
        const int h = i / BT_N, idx = i % BT_N;
        BT[i] = PP(rel_bias)[rel_bucket(idx - BT_OFF) * NH + h] * LOG2E;
    }
    if (blockIdx.x == 0 && wave < DEPTH) {
        const int l = wave;
        const float a = wave_sum(PP(lam_q1)[l * 64 + lane] * PP(lam_k1)[l * 64 + lane]);
        const float b = wave_sum(PP(lam_q2)[l * 64 + lane] * PP(lam_k2)[l * 64 + lane]);
        const float lam_init = 0.8f - 0.6f * expf(-0.3f * (float)l);
        if (lane == 0) ((float*)(P_WS + WS_LAM))[l] = expf(a) - expf(b) + lam_init;
    }
}

template <bool FIRST, bool LAST>
__device__ __forceinline__ void p4_body(unsigned char* lds, int l, const bool dry) {
    const int tid = opaque_tid(), lane = tid & 63, wave = __builtin_amdgcn_readfirstlane(tid >> 6);
    const int gw = wave * gridDim.x + blockIdx.x, NGW = gridDim.x * 8;
    const float* GP = (const float*)lds; const float* GN = (const float*)(lds + 8192);
    const bf16* Xr = (const bf16*)(P_WS + WS_X); const bf16* Y = (const bf16*)(P_WS + WS_Y); const float* PART = (const float*)(P_WS + WS_PART);
    bf16* Xw = (bf16*)(P_WS + (dry ? WS_PROJ : WS_X)); bf16* U = (bf16*)(P_WS + (dry ? WS_PROJ + 66 * MiB : WS_U));
    float* OUT = P_OUT; float* DRY = (float*)(P_WS + WS_PROJ);
    const float* xin_p = PP(x_prompt); const float* xin_s = PP(x_sample); const float* xin_m = PP(meta);
    for (int it = 0; ; ++it) {
        const int r0 = gw + 2 * it * NGW;
        if (r0 >= MTOT) break;
        int rr[2]; rr[0] = r0; rr[1] = r0 + NGW; const bool has2 = rr[1] < MTOT; if (!has2) rr[1] = r0;
        f32x4 y[2][8], x[2][8];
#pragma unroll
        for (int q = 0; q < 2; ++q) {
            const int r = rr[q];
            if (r < TAIL_ROW0) {
#pragma unroll
                for (int j = 0; j < 8; ++j) { const u32x2 raw = *(const u32x2*)(Y + (size_t)r * D_MODEL + 4 * lane + 256 * j); y[q][j] = (f32x4){bflo(raw.x), bfhi(raw.x), bflo(raw.y), bfhi(raw.y)}; }
            } else {
                const float* pr = PART + (size_t)(r - TAIL_ROW0) * D_MODEL + 4 * lane;
#pragma unroll
                for (int j = 0; j < 8; ++j) y[q][j] = *(const f32x4*)(pr + 256 * j);
#pragma unroll 3
                for (int kp = 1; kp < TAIL_KP; ++kp) {
                    f32x4 t[8];
#pragma unroll
                    for (int j = 0; j < 8; ++j) t[j] = *(const f32x4*)(pr + (size_t)kp * TAIL_ROWS * D_MODEL + 256 * j);
#pragma unroll
                    for (int j = 0; j < 8; ++j) y[q][j] = y[q][j] + t[j];
                }
            }
            if (FIRST) {
                const float* src;
                if (r < MP) { const int b = r / LP, pos = r % LP; src = pos < NMETA ? xin_m + (size_t)pos * D_MODEL : xin_p + ((size_t)b * SEQ + (pos - NMETA)) * D_MODEL; }
                else src = xin_s + (size_t)(r - MP) * D_MODEL;
#pragma unroll
                for (int j = 0; j < 8; ++j) x[q][j] = *(const f32x4*)(src + 4 * lane + 256 * j);
            } else {
#pragma unroll
                for (int j = 0; j < 8; ++j) { const u32x2 raw = *(const u32x2*)(Xr + (size_t)r * D_MODEL + 4 * lane + 256 * j); x[q][j] = (f32x4){bflo(raw.x), bfhi(raw.x), bflo(raw.y), bfhi(raw.y)}; }
            }
        }
#pragma unroll
        for (int q = 0; q < 2; ++q) {
            const int r = rr[q];
            if (q == 1 && !has2) break;
            float ss = 0.f;
#pragma unroll
            for (int j = 0; j < 8; ++j) ss += (y[q][j][0] * y[q][j][0] + y[q][j][1] * y[q][j][1]) + (y[q][j][2] * y[q][j][2] + y[q][j][3] * y[q][j][3]);
            const float rs = rsqrtf(wave_sum(ss) * (1.f / D_MODEL) + EPS);
#pragma unroll
            for (int j = 0; j < 8; ++j) { const f32x4 gg = *(const f32x4*)(GP + 4 * lane + 256 * j); x[q][j] = x[q][j] + y[q][j] * rs * gg; }
            if (!LAST) {
                float s2 = 0.f;
#pragma unroll
                for (int j = 0; j < 8; ++j) s2 += (x[q][j][0] * x[q][j][0] + x[q][j][1] * x[q][j][1]) + (x[q][j][2] * x[q][j][2] + x[q][j][3] * x[q][j][3]);
                const float r2 = rsqrtf(wave_sum(s2) * (1.f / D_MODEL) + EPS);
#pragma unroll
                for (int j = 0; j < 8; ++j) {
                    const f32x4 gn = *(const f32x4*)(GN + 4 * lane + 256 * j);
                    u32x2 o; o.x = pk2(x[q][j][0], x[q][j][1]); o.y = pk2(x[q][j][2], x[q][j][3]); *(u32x2*)(Xw + (size_t)r * D_MODEL + 4 * lane + 256 * j) = o;
                    u32x2 u; u.x = pk2(x[q][j][0] * r2 * gn[0], x[q][j][1] * r2 * gn[1]); u.y = pk2(x[q][j][2] * r2 * gn[2], x[q][j][3] * r2 * gn[3]); *(u32x2*)(U + (size_t)r * D_MODEL + 4 * lane + 256 * j) = u;
                }
            } else {
                float* dst = nullptr;
                if (r < MP) { const int b = r / LP, pos = r % LP; if (pos >= NMETA) dst = OUT + O_YP + ((size_t)b * SEQ + (pos - NMETA)) * D_MODEL; }
                else dst = OUT + O_YS + (size_t)(r - MP) * D_MODEL;
                if (dry) dst = DRY + (size_t)r * D_MODEL;
                if (dst) {
#pragma unroll
                    for (int j = 0; j < 8; ++j) *(f32x4*)(dst + 4 * lane + 256 * j) = x[q][j];
                }
            }
        }
    }
}
__device__ __forceinline__ void p4_rowpass(unsigned char* lds, int l, const bool dry = false) {
    {
        const int tid = opaque_tid();
        const float* pg = PP(post_g) + (size_t)l * D_MODEL; const float* ng = PP(pre_g) + (size_t)(l + 1 < DEPTH ? l + 1 : l) * D_MODEL;
        *(f32x4*)(lds + 16 * tid) = *(const f32x4*)(pg + 4 * tid); *(f32x4*)(lds + 8192 + 16 * tid) = *(const f32x4*)(ng + 4 * tid);
        __syncthreads();
    }
    if (l == 0) p4_body<true, false>(lds, l, dry);
    else if (l == DEPTH - 1) p4_body<false, true>(lds, l, dry);
    else p4_body<false, false>(lds, l, dry);
}

constexpr int RG_XAB = 0, RG_XCB = 16896, RG_WT = 35328, RG_AL = 53760, RG_BL = 86528, RG_SA = 119296, RG_SH = 121344, RG_HC = 123392, RG_SP = 123904, RG_BR = 124160, RG_BI = 124416, RG_CW = 124672;
static_assert(RG_CW + 1280 <= 131072, "rglru LDS map");
__device__ __forceinline__ void rglru_unit(int l, int b, int n, const bool SAMPLE, unsigned char* lds) {
    const int tid = opaque_tid(), lane = tid & 63, w = __builtin_amdgcn_readfirstlane(tid >> 6), c16 = lane & 15, g = lane >> 4;
    const int T = SAMPLE ? DEC_T : LP;
    const int rowbase = SAMPLE ? MP + b * DEC_T : b * LP;
    const int c0 = n * 64;
    const bf16* PROJ = (const bf16*)(P_WS + WS_PROJ); bf16* YAB = (bf16*)(P_WS + WS_YAB);
    unsigned char* XAB = lds + RG_XAB; unsigned char* XCB = lds + RG_XCB; unsigned char* WT = lds + RG_WT;
    float* AL = (float*)(lds + RG_AL); float* BL = (float*)(lds + RG_BL); float* SA = (float*)(lds + RG_SA); float* SH = (float*)(lds + RG_SH); float* HC = (float*)(lds + RG_HC);
    float* SP = (float*)(lds + RG_SP); float* BR = (float*)(lds + RG_BR); float* BI = (float*)(lds + RG_BI); float* CW = (float*)(lds + RG_CW);
    {
        const float* wr = PP(gate_r_w) + ((size_t)l * 16 + n) * 4096; const float* wi = PP(gate_i_w) + ((size_t)l * 16 + n) * 4096;
#pragma unroll
        for (int i = 0; i < 8; ++i) { const int e = tid + 512 * i, c = e >> 6, d = e & 63;
            *(bf16*)(WT + d * 144 + c * 2) = (bf16)f2bf(wr[e]); *(bf16*)(WT + 9216 + d * 144 + c * 2) = (bf16)f2bf(wi[e]); }
        if (tid < 64) {
            const float lamv = PP(rglru_lam)[l * D_A + c0 + tid];
            SP[tid] = log1pf(expf(-lamv));
            BR[tid] = PP(gate_r_b)[(l * 16 + n) * 64 + tid]; BI[tid] = PP(gate_i_b)[(l * 16 + n) * 64 + tid];
            HC[tid] = SAMPLE ? PP(state_rglru)[((size_t)l * NBATCH + b) * D_A + c0 + tid] : 0.f;
        }
        if (tid < 320) { const int j = tid >> 6, d = tid & 63; CW[tid] = (j < 4) ? PP(conv_w)[((size_t)l * 4 + j) * D_A + c0 + d] : PP(conv_b)[l * D_A + c0 + d]; }
    }
    const int tq = tid >> 3, cg8 = tid & 7;
    const int nchunks = (T + 127) >> 7;
    const bf16* xa_base = PROJ + (size_t)rowbase * IN_COLS + C_XA + c0;
    const bf16* ga_base = PROJ + (size_t)rowbase * IN_COLS + C_GA + c0 + 8 * cg8;
    u32x4 pxa[3], pga[2];
#define RG_FETCH(ck_) do { \
        _Pragma("unroll") for (int k = 0; k < 3; ++k) { const int id = tid + 512 * k, i = id >> 3, cg = id & 7, tk = (ck_) * 128 - 3 + i; \
            pxa[k] = (u32x4){0u, 0u, 0u, 0u}; \
            if (id < 131 * 8 && tk >= 0 && tk < T) pxa[k] = *(const u32x4*)(xa_base + (size_t)tk * IN_COLS + 8 * cg); } \
        _Pragma("unroll") for (int k = 0; k < 2; ++k) { const int tk = (ck_) * 128 + tq + 64 * k; pga[k] = (u32x4){0u, 0u, 0u, 0u}; \
            if (tk < T) pga[k] = *(const u32x4*)(ga_base + (size_t)tk * IN_COLS); } \
    } while (0)
    RG_FETCH(0);
    for (int ck = 0; ck < nchunks; ++ck) {
        const int t0 = ck * 128;
#pragma unroll
        for (int k = 0; k < 3; ++k) {
            const int id = tid + 512 * k, i = id >> 3, cg = id & 7, tk = t0 - 3 + i;
            if (id < 131 * 8) {
                u32x4 raw = pxa[k];
                if (SAMPLE && tk < 0) { const float* sc = PP(state_conv) + (((size_t)l * NBATCH + b) * 3 + (3 + tk)) * D_A + c0 + 8 * cg; const f32x4 lo = *(const f32x4*)sc, hi = *(const f32x4*)(sc + 4);
                    raw.x = pk2(lo[0], lo[1]); raw.y = pk2(lo[2], lo[3]); raw.z = pk2(hi[0], hi[1]); raw.w = pk2(hi[2], hi[3]); }
                *(u32x4*)(XAB + i * 128 + cg * 16) = raw;
            }
        }
        const u32x4 ga0 = pga[0], ga1 = pga[1];
        if (ck + 1 < nchunks) RG_FETCH(ck + 1);
        LDS_BARRIER();
#pragma unroll
        for (int k = 0; k < 2; ++k) {
            const int t = tq + 64 * k;
            float xc[8];
            { const f32x4 c0v = *(const f32x4*)(CW + 256 + 8 * cg8), c1v = *(const f32x4*)(CW + 256 + 8 * cg8 + 4);
#pragma unroll
              for (int e = 0; e < 4; ++e) { xc[e] = c0v[e]; xc[4 + e] = c1v[e]; } }
#pragma unroll
            for (int j = 0; j < 4; ++j) {
                const u32x4 raw = *(const u32x4*)(XAB + (t + j) * 128 + cg8 * 16);
                const f32x4 w0 = *(const f32x4*)(CW + j * 64 + 8 * cg8), w1 = *(const f32x4*)(CW + j * 64 + 8 * cg8 + 4);
                xc[0] += w0[0] * bflo(raw.x); xc[1] += w0[1] * bfhi(raw.x); xc[2] += w0[2] * bflo(raw.y); xc[3] += w0[3] * bfhi(raw.y);
                xc[4] += w1[0] * bflo(raw.z); xc[5] += w1[1] * bfhi(raw.z); xc[6] += w1[2] * bflo(raw.w); xc[7] += w1[3] * bfhi(raw.w);
            }
            u32x4 o; o.x = pk2(xc[0], xc[1]); o.y = pk2(xc[2], xc[3]); o.z = pk2(xc[4], xc[5]); o.w = pk2(xc[6], xc[7]);
            *(u32x4*)(XCB + t * 144 + cg8 * 16) = o;
        }
        LDS_BARRIER();
        {
            const bf16x8 a0 = *(const bf16x8*)(XCB + (16 * w + c16) * 144 + 16 * g), a1 = *(const bf16x8*)(XCB + (16 * w + c16) * 144 + 64 + 16 * g);
#pragma unroll
            for (int db = 0; db < 4; ++db) {
                const unsigned char* wp = WT + (16 * db + c16) * 144 + 16 * g;
                const bf16x8 r0 = *(const bf16x8*)wp, r1 = *(const bf16x8*)(wp + 64), i0 = *(const bf16x8*)(wp + 9216), i1 = *(const bf16x8*)(wp + 9216 + 64);
                f32x4 ar = {0.f, 0.f, 0.f, 0.f}, ai = {0.f, 0.f, 0.f, 0.f};
                ar = MFMA16(a0, r0, ar); ar = MFMA16(a1, r1, ar); ai = MFMA16(a0, i0, ai); ai = MFMA16(a1, i1, ai);
                const int d = 16 * db + c16;
                const float brv = BR[d], biv = BI[d], spv = SP[d];
#pragma unroll
                for (int r = 0; r < 4; ++r) {
                    const int t = 16 * w + 4 * g + r;
                    const float xcv = bflo((unsigned)*(const bf16*)(XCB + t * 144 + d * 2));
                    const float la = -8.0f * sigmoidf_(ar[r] + brv) * spv;
                    const float a = __expf(la), t2 = 2.0f * la;
                    const float ser = -t2 * (1.0f + t2 * 0.5f * (1.0f + t2 * (1.0f / 3.0f) * (1.0f + t2 * 0.25f * (1.0f + t2 * 0.2f))));
                    const float om = (t2 > -0.125f) ? ser : (1.0f - a * a);
                    const float bb = __builtin_amdgcn_sqrtf(om) * (sigmoidf_(ai[r] + biv) * xcv);
                    const bool valid = (t0 + t) < T;
                    AL[t * 64 + d] = valid ? a : 1.f; BL[t * 64 + d] = valid ? bb : 0.f;
                }
            }
        }
        LDS_BARRIER();
        {
            float cum = 1.f, hl = 0.f;
#pragma unroll
            for (int i = 0; i < 16; ++i) { const int ix = (16 * w + i) * 64 + lane; const float a = AL[ix], bb = BL[ix]; hl = a * hl + bb; cum *= a; AL[ix] = cum; BL[ix] = hl; }
            SA[w * 64 + lane] = cum; SH[w * 64 + lane] = hl;
        }
        LDS_BARRIER();
        {
            float hin = HC[(ck & 1) * 64 + lane];
#pragma unroll
            for (int ww = 0; ww < 7; ++ww) { const float sa = SA[ww * 64 + lane], sh = SH[ww * 64 + lane]; if (ww < w) hin = sa * hin + sh; }
            float h = hin;
#pragma unroll
            for (int i = 0; i < 16; ++i) { const int ix = (16 * w + i) * 64 + lane; h = AL[ix] * hin + BL[ix]; BL[ix] = h; }
            if (w == 7) HC[((ck + 1) & 1) * 64 + lane] = h;
        }
        LDS_BARRIER();
#pragma unroll
        for (int k = 0; k < 2; ++k) {
            const int t = tq + 64 * k;
            if (t0 + t < T) {
                const size_t row = (size_t)(rowbase + t0 + t);
                const u32x4 raw = k ? ga1 : ga0;
                const f32x4 h0 = *(const f32x4*)(BL + t * 64 + 8 * cg8), h1 = *(const f32x4*)(BL + t * 64 + 8 * cg8 + 4);
                u32x4 o;
                o.x = pk2(h0[0] * siluf_(bflo(raw.x)), h0[1] * siluf_(bfhi(raw.x))); o.y = pk2(h0[2] * siluf_(bflo(raw.y)), h0[3] * siluf_(bfhi(raw.y)));
                o.z = pk2(h1[0] * siluf_(bflo(raw.z)), h1[1] * siluf_(bfhi(raw.z))); o.w = pk2(h1[2] * siluf_(bflo(raw.w)), h1[3] * siluf_(bfhi(raw.w)));
                *(u32x4*)(YAB + row * D_MODEL + c0 + 8 * cg8) = o;
            }
        }
    }
#undef RG_FETCH
    float* o_r = P_OUT + (SAMPLE ? O_RS : O_RP) + ((size_t)l * NBATCH + b) * D_A + c0;
    float* o_c = P_OUT + (SAMPLE ? O_CS : O_CP) + ((size_t)l * NBATCH + b) * 3 * D_A + c0;
    if (tid < 64) o_r[tid] = HC[(nchunks & 1) * 64 + tid];
    if (tid < 192) { const int i = tid >> 6, d = tid & 63; o_c[(size_t)i * D_A + d] = bflo((unsigned)PROJ[(size_t)(rowbase + T - 3 + i) * IN_COLS + C_XA + c0 + d]); }
}

constexpr int AT_K = 0, AT_KB = 17408, AT_V = 34816, AT_VB = 18432, AT_BT = 71680;
__device__ __forceinline__ void attn_unit(int l, int b, int h, int j, unsigned char* lds) {
    const int tid = opaque_tid(), lane = tid & 63, w = __builtin_amdgcn_readfirstlane(tid >> 6), c16 = lane & 15, g = lane >> 4;
    const bool SAMPLE = (j == -2);
    const bf16* PROJ = (const bf16*)(P_WS + WS_PROJ); bf16* YAB = (bf16*)(P_WS + WS_YAB);
    float* BT = (float*)(lds + AT_BT);
    const float lam = ((const float*)(P_WS + WS_LAM))[l];
    const float lam_init = 0.8f - 0.6f * expf(-0.3f * (float)l);
    int ntiles, nkeys_w, qpos, qrow;
    if (SAMPLE) { ntiles = 33; nkeys_w = (w < 2) ? (PAST + DEC_T) : 0; qpos = PAST + 16 * w + c16; qrow = MP + b * DEC_T + 16 * w + c16; }
    else if (j >= 0) { ntiles = 2 * j + 3; nkeys_w = 80 + 64 * (2 * j + (w >> 2)); qpos = NMETA + 128 * j + 16 * w + c16; qrow = b * LP + qpos; }
    else { ntiles = 1; nkeys_w = (w == 0) ? NMETA : 0; qpos = 16 * w + c16; qrow = b * LP + qpos; }
    const int ntw = (nkeys_w + 63) >> 6;
    bf16x8 qf[2][2];
    {
        const bf16* qp = PROJ + (size_t)qrow * IN_COLS + C_Q + h * 128 + 8 * g;
#pragma unroll
        for (int mp = 0; mp < 2; ++mp)
#pragma unroll
            for (int ks = 0; ks < 2; ++ks) qf[mp][ks] = *(const bf16x8*)(qp + mp * 64 + ks * 32);
    }
    for (int i = tid; i < BT_LDS; i += NTHREADS) BT[i] = (i < BT_N) ? ((const float*)(P_WS + WS_BT))[h * BT_N + i] : 0.f;
    u32x4 skA[2], svA[2], skB[2], svB[2];
    const int sr0 = tid >> 4, sch = tid & 15;
    const float* CKF = PP(cache_k) + (((size_t)l * NBATCH + b) * PAST) * 1024 + h * 128 + sch * 8;
    const float* CVF = PP(cache_v) + (((size_t)l * NBATCH + b) * PAST) * 1024 + h * 128 + sch * 8;
#define AT_LOAD(t, SK, SV) do { \
        _Pragma("unroll") for (int i = 0; i < 2; ++i) { const int r = sr0 + 32 * i; \
            { int krow; \
                if (SAMPLE) { const int rr = r < DEC_T ? r : DEC_T - 1; krow = MP + b * DEC_T + rr; } \
                else { int kp_ = 64 * (t) + r; kp_ = kp_ < LP ? kp_ : LP - 1; krow = b * LP + kp_; } \
                const bf16* src = PROJ + (size_t)krow * IN_COLS + h * 128 + sch * 8; \
                SK[i] = *(const u32x4*)(src + C_K); SV[i] = *(const u32x4*)(src + C_V); } \
        } } while (0)
#define AT_STORE(t, buf, vbuf, SK, SV) do { \
        _Pragma("unroll") for (int i = 0; i < 2; ++i) { const int r = sr0 + 32 * i; \
            *(u32x4*)(lds + AT_K + (buf) * AT_KB + r * 272 + sch * 16) = SK[i]; *(u32x4*)(lds + AT_V + (vbuf) * AT_VB + r * 288 + sch * 16) = SV[i]; \
        } } while (0)
float mrun[2]; f32x4 lacc[2];
    f32x4 O[2][8];
#if DUP_LOOP
    for (int rep_ = 0; rep_ < 2; ++rep_) {
    if (rep_) __syncthreads();
#endif
#pragma unroll
    for (int mp = 0; mp < 2; ++mp)
#pragma unroll
        for (int blk = 0; blk < 8; ++blk) O[mp][blk] = (f32x4){0.f, 0.f, 0.f, 0.f};
    mrun[0] = mrun[1] = 0.f; lacc[0] = lacc[1] = (f32x4){0.f, 0.f, 0.f, 0.f};
    const float SC = 0.125f * LOG2E;
    f32x4 s[2][4]; bf16x8 pf[2][2];
    const unsigned char* vrd = lds + AT_V + (4 * g + (c16 >> 2)) * 288 + (c16 & 3) * 8;
#define AT_PVSTEP(vb_, PF, st, blk) do { \
        const s16x4 lo_ = vtr((vb_) + (32 * (st)) * 288 + (blk) * 32), hi_ = vtr((vb_) + (32 * (st) + 16) * 288 + (blk) * 32); \
        const bf16x8 vf_ = __builtin_shufflevector(lo_, hi_, 0, 1, 2, 3, 4, 5, 6, 7); \
        O[0][blk] = MFMA16(vf_, PF[0][st], O[0][blk]); O[1][blk] = MFMA16(vf_, PF[1][st], O[1][blk]); } while (0)
#define AT_EXPSTEP(mp, kb) do { f32x4 e_; \
        _Pragma("unroll") for (int r = 0; r < 4; ++r) e_[r] = __builtin_amdgcn_exp2f(s[mp][kb][r] - mrun[mp]); \
        if (DUP_EXP) { f32x4 d_; _Pragma("unroll") for (int r = 0; r < 4; ++r) d_[r] = __builtin_amdgcn_exp2f(s[mp][kb][r] - mrun[mp] - 1.0f); lacc[mp] = lacc[mp] + d_ * 0.f; } \
        s[mp][kb] = e_; lacc[mp] = lacc[mp] + e_; } while (0)
#define AT_PACK(PF) do { _Pragma("unroll") for (int mp = 0; mp < 2; ++mp) _Pragma("unroll") for (int st = 0; st < 2; ++st) { \
        u32x4 pk_; pk_.x = pk2(s[mp][2 * st][0], s[mp][2 * st][1]); pk_.y = pk2(s[mp][2 * st][2], s[mp][2 * st][3]); \
        pk_.z = pk2(s[mp][2 * st + 1][0], s[mp][2 * st + 1][1]); pk_.w = pk2(s[mp][2 * st + 1][2], s[mp][2 * st + 1][3]); \
        PF[mp][st] = __builtin_bit_cast(bf16x8, pk_); } } while (0)
#define AT_COMPUTE(t) do { \
        if (t < ntw) { \
            const unsigned char* kb_ = lds + AT_K + (t & 1) * AT_KB + c16 * 272 + 16 * g; \
            const unsigned char* vb_ = vrd + (t & 1) * AT_VB; \
            const int kbase = 64 * t + 4 * g; \
            const bool need_mask = (64 * t + 64 > nkeys_w); \
            float bias[4][4]; \
_Pragma("unroll") \
            for (int kh = 0; kh < 2; ++kh) { \
                bf16x8 kf[2][2][2]; \
_Pragma("unroll") \
                for (int kb = 0; kb < 2; ++kb) \
_Pragma("unroll") \
                    for (int mp = 0; mp < 2; ++mp) \
_Pragma("unroll") \
                        for (int ks = 0; ks < 2; ++ks) kf[kb][mp][ks] = *(const bf16x8*)(kb_ + (2 * kh + kb) * (16 * 272) + mp * 128 + ks * 64); \
_Pragma("unroll") \
                for (int kb = 0; kb < 2; ++kb) \
_Pragma("unroll") \
                    for (int mp = 0; mp < 2; ++mp) { \
                        f32x4 a = {0.f, 0.f, 0.f, 0.f}; \
_Pragma("unroll") \
                        for (int ks = 0; ks < 2; ++ks) a = MFMA16(kf[kb][mp][ks], qf[mp][ks], a); \
                        s[mp][2 * kh + kb] = a; \
                    } \
                __builtin_amdgcn_sched_barrier(0); \
            } \
_Pragma("unroll") \
            for (int kb = 0; kb < 4; ++kb) \
_Pragma("unroll") \
                for (int r = 0; r < 4; ++r) bias[kb][r] = BT[kbase + 16 * kb + r - qpos + BT_OFF]; \
_Pragma("unroll") \
            for (int mp = 0; mp < 2; ++mp) \
_Pragma("unroll") \
                for (int kb = 0; kb < 4; ++kb) s[mp][kb] = s[mp][kb] * SC + (f32x4){bias[kb][0], bias[kb][1], bias[kb][2], bias[kb][3]}; \
            if (need_mask) { \
_Pragma("unroll") \
                for (int mp = 0; mp < 2; ++mp) \
_Pragma("unroll") \
                    for (int kb = 0; kb < 4; ++kb) \
_Pragma("unroll") \
                        for (int r = 0; r < 4; ++r) if (kbase + 16 * kb + r >= nkeys_w) s[mp][kb][r] = -1e30f; \
            } \
            if (t == 0) { \
_Pragma("unroll") \
                for (int mp = 0; mp < 2; ++mp) { \
                    float mx = -1e30f; \
_Pragma("unroll") \
                    for (int kb = 0; kb < 4; ++kb) mx = fmaxf(fmaxf(mx, fmaxf(s[mp][kb][0], s[mp][kb][1])), fmaxf(s[mp][kb][2], s[mp][kb][3])); \
                    mx = fmaxf(mx, __shfl_xor(mx, 16)); mx = fmaxf(mx, __shfl_xor(mx, 32)); \
                    mrun[mp] = mx; \
                } \
            } \
_Pragma("unroll") \
            for (int mp = 0; mp < 2; ++mp) \
_Pragma("unroll") \
                for (int kb = 0; kb < 4; ++kb) AT_EXPSTEP(mp, kb); \
            AT_PACK(pf); \
_Pragma("unroll") \
            for (int st = 0; st < 2; ++st) \
_Pragma("unroll") \
                for (int blk = 0; blk < 8; ++blk) AT_PVSTEP(vb_, pf, st, blk); \
        } \
    } while (0)
#define AT_ITER(t, FARK, FARV, NEARK, NEARV) do { \
        { const int tf_ = ((t) + 2 < ntiles) ? (t) + 2 : ntiles - 1; AT_LOAD(tf_, FARK, FARV); }     \
        AT_COMPUTE((t)); \
        if ((t) + 1 < ntiles) AT_STORE((t) + 1, ((t) + 1) & 1, ((t) + 1) & 1, NEARK, NEARV); \
        LDS_BARRIER(); } while (0)
    if (!SAMPLE) {
        AT_LOAD(0, skB, svB); AT_STORE(0, 0, 0, skB, svB);
        { const int t1_ = (1 < ntiles) ? 1 : 0; AT_LOAD(t1_, skA, svA); }
        LDS_BARRIER();
        for (int t = 0; t < ntiles; t += 2) {
            AT_ITER(t, skB, svB, skA, svA);
            if (t + 1 < ntiles) AT_ITER(t + 1, skA, svA, skB, svB);
        }
    } else {
        f32x4 fk[2][2], fv[2][2];
#define AT_LOADF(t) do { _Pragma("unroll") for (int i = 0; i < 2; ++i) { const size_t off = (size_t)(64 * (t) + sr0 + 32 * i) * 1024; \
            fk[i][0] = *(const f32x4*)(CKF + off); fk[i][1] = *(const f32x4*)(CKF + off + 4); fv[i][0] = *(const f32x4*)(CVF + off); fv[i][1] = *(const f32x4*)(CVF + off + 4); } } while (0)
#define AT_STOREF(buf) do { _Pragma("unroll") for (int i = 0; i < 2; ++i) { const int r = sr0 + 32 * i; u32x4 ck_, cv_; \
            ck_.x = pk2(fk[i][0][0], fk[i][0][1]); ck_.y = pk2(fk[i][0][2], fk[i][0][3]); ck_.z = pk2(fk[i][1][0], fk[i][1][1]); ck_.w = pk2(fk[i][1][2], fk[i][1][3]); \
            cv_.x = pk2(fv[i][0][0], fv[i][0][1]); cv_.y = pk2(fv[i][0][2], fv[i][0][3]); cv_.z = pk2(fv[i][1][0], fv[i][1][1]); cv_.w = pk2(fv[i][1][2], fv[i][1][3]); \
            *(u32x4*)(lds + AT_K + (buf) * AT_KB + r * 272 + sch * 16) = ck_; *(u32x4*)(lds + AT_V + (buf) * AT_VB + r * 288 + sch * 16) = cv_; } } while (0)
        AT_LOADF(0); AT_STOREF(0);
        LDS_BARRIER();
#pragma nounroll
        for (int t = 0; t < 33; ++t) {
            if (t + 1 < 32) AT_LOADF(t + 1); else if (t + 1 == 32) AT_LOAD(32, skA, svA);
            AT_COMPUTE(t);
            if (t + 1 < 32) AT_STOREF((t + 1) & 1); else if (t + 1 == 32) AT_STORE(32, 0, 0, skA, svA);
            LDS_BARRIER();
        }
#undef AT_LOADF
#undef AT_STOREF
    }
#undef AT_ITER
#undef AT_COMPUTE
#undef AT_PVSTEP
#undef AT_EXPSTEP
#undef AT_PACK
#undef AT_LOAD
#undef AT_STORE
    if (nkeys_w > 0) {
        float l0 = (lacc[0][0] + lacc[0][1]) + (lacc[0][2] + lacc[0][3]), l1 = (lacc[1][0] + lacc[1][1]) + (lacc[1][2] + lacc[1][3]);
        l0 += __shfl_xor(l0, 16); l0 += __shfl_xor(l0, 32); l1 += __shfl_xor(l1, 16); l1 += __shfl_xor(l1, 32);
        const float inv1 = 1.f / l0, inv2 = lam / l1;
        float ss = 0.f;
#pragma unroll
        for (int blk = 0; blk < 8; ++blk)
#pragma unroll
            for (int r = 0; r < 4; ++r) { const float o = O[0][blk][r] * inv1 - O[1][blk][r] * inv2; O[0][blk][r] = o; ss += o * o; }
        ss += __shfl_xor(ss, 16); ss += __shfl_xor(ss, 32);
        const float rn = rsqrtf(ss * (1.f / 128.f) + EPS) * (1.f - lam_init);
        const bf16* gbp = PROJ + (size_t)qrow * IN_COLS + C_GB + h * 128 + 4 * g;
        const float* sg = PP(subln_g) + l * 128 + 4 * g;
        bf16* yo = YAB + (size_t)qrow * D_MODEL + D_A + h * 128 + 4 * g;
#pragma unroll
        for (int blk = 0; blk < 8; ++blk) {
            const u32x2 gr = *(const u32x2*)(gbp + 16 * blk); const f32x4 sgv = *(const f32x4*)(sg + 16 * blk);
            u32x2 o;
            o.x = pk2(O[0][blk][0] * rn * sgv[0] * siluf_(bflo(gr.x)), O[0][blk][1] * rn * sgv[1] * siluf_(bfhi(gr.x)));
            o.y = pk2(O[0][blk][2] * rn * sgv[2] * siluf_(bflo(gr.y)), O[0][blk][3] * rn * sgv[3] * siluf_(bfhi(gr.y)));
            *(u32x2*)(yo + 16 * blk) = o;
        }
    }
}

constexpr int Q_UNITS = 176;
constexpr int CW_TAIL = 512, TAIL_TILES = 48;
__device__ __forceinline__ void tail_signal(unsigned char* lds, int l) {
    asm volatile("s_waitcnt vmcnt(0)" ::: "memory");
    __syncthreads();
    if (threadIdx.x == 0) {
        __builtin_amdgcn_fence(__ATOMIC_RELEASE, "agent");
        asm volatile("s_waitcnt vmcnt(0)" ::: "memory");
        (void)__hip_atomic_fetch_add((unsigned*)(P_WS + WS_CTL) + CW_TAIL + 64 * l, 1u, __ATOMIC_RELAXED, __HIP_MEMORY_SCOPE_AGENT);
    }
}
__device__ __forceinline__ void tail_wait(unsigned char* lds, int l) {
    if (threadIdx.x == 0) {
        unsigned* p = (unsigned*)(P_WS + WS_CTL) + CW_TAIL + 64 * l;
        const unsigned need = gridDim.x < (unsigned)TAIL_TILES ? gridDim.x : (unsigned)TAIL_TILES;
        unsigned sp = 0u;
        while (__hip_atomic_load(p, __ATOMIC_RELAXED, __HIP_MEMORY_SCOPE_AGENT) < need) { __builtin_amdgcn_s_sleep(2); if (++sp > (1u << 22)) break; }
        __builtin_amdgcn_fence(__ATOMIC_ACQUIRE, "agent");
        asm volatile("s_waitcnt vmcnt(0)" ::: "memory");
    }
    __syncthreads();
}
__device__ __forceinline__ void p2_mixers(int l, unsigned char* lds, int rep = 0) {
    unsigned* ctr = (unsigned*)(P_WS + WS_CTL) + l * 8 + rep * 64;
    volatile int* slot = (volatile int*)(lds + LDS_SLOT);
    const int tid = opaque_tid();
    bool tail_ok = false;
    for (int qq = 0; qq < 8; ++qq) {
        const int b = (blockIdx.x + qq) & 7;
        for (;;) {
            __syncthreads();
            if (tid == 0) *slot = (int)atomicAdd(ctr + b, 1u);
            __syncthreads();
            const int u = __builtin_amdgcn_readfirstlane(*slot);
            if (u >= Q_UNITS) break;
            const int blk8 = u >> 3, idx = u & 7;
            int type, n = 0, j = 0;
            if (blk8 >= 20) { type = 2; n = u - 160; }
            else if (blk8 == 19) { type = 1; j = -1; }
            else if (b != 7) {
                if (blk8 < 2) { type = 0; n = u; }
                else if (blk8 == 2) { type = 1; j = 15; } else if (blk8 == 3) { type = 1; j = 14; } else if (blk8 == 4) { type = 1; j = -2; }
                else { type = 1; j = 18 - blk8; }
            } else {
                if (blk8 < 3) { type = 1; j = 14 - blk8; }
                else if (blk8 < 5) { type = 0; n = u - 24; }
                else if (blk8 == 5) { type = 1; j = 15; } else if (blk8 == 6) { type = 1; j = -2; }
                else { type = 1; j = 18 - blk8; }
            }
            const bool dep = (type == 2) || (type == 1 && j == -2) || (b == 7 && (type == 0 || (type == 1 && j == 15)));
            if (dep && !tail_ok) { tail_wait(lds, l); tail_ok = true; }
            if (type != 1) rglru_unit(l, b, n, type == 2, lds);
            else attn_unit(l, b, idx, j, lds);
        }
    }
}

#define XB_TMO      128
#define XB_XCNT(j)  (256  + 64 * (j))
#define XB_XSUB(j)  (1280 + 64 * (j))
#define XB_XGEN(j)  (2304 + 64 * (j))
#define XB_TOP      3328
#define XB_TOPGEN   3392
#define XCD_BAR_WORDS 3456
#define XB_SPIN_CAP (1u << 18)

__device__ __forceinline__ unsigned xb_ld(unsigned* p)              { return __hip_atomic_load(p, __ATOMIC_RELAXED, __HIP_MEMORY_SCOPE_AGENT); }
__device__ __forceinline__ unsigned xb_add(unsigned* p, unsigned v) { return __hip_atomic_fetch_add(p, v, __ATOMIC_RELAXED, __HIP_MEMORY_SCOPE_AGENT); }
__device__ __forceinline__ unsigned xb_xcc_id() { return (unsigned)__builtin_amdgcn_s_getreg((3 << 11) | 20) & 0xFu; }
#define XB_SPIN(cond, bar) do { unsigned _sp = 0; while (cond) { __builtin_amdgcn_s_sleep(1); \
    if ((++_sp & 255u) == 0u) { if (xb_ld(&(bar)[XB_TMO])) break; if (_sp > XB_SPIN_CAP) { atomicAdd(&(bar)[XB_TMO], 1u); break; } } } } while (0)

struct XcdBarrier {
    unsigned* bar; unsigned x;
    volatile LAS unsigned* st;
};

__device__ __forceinline__ XcdBarrier xcd_barrier_post(unsigned* bar, volatile LAS unsigned* st) {
    XcdBarrier b; b.bar = bar; b.x = xb_xcc_id(); b.st = st;
    if (threadIdx.x == 0) (void)xb_add(&bar[XB_XCNT(b.x)], 1u);
    return b;
}
__device__ __forceinline__ void xcd_barrier_complete(unsigned* bar, unsigned x, unsigned& nloc, unsigned& nx) {
    const unsigned G = gridDim.x * gridDim.y * gridDim.z;
    unsigned sum, cnt, mine, sp = 0u;
    for (;;) {
        sum = 0u; cnt = 0u; mine = 0u;
#pragma unroll
        for (unsigned j = 0; j < 16; ++j) { const unsigned c = xb_ld(&bar[XB_XCNT(j)]); sum += c; cnt += (c > 0u) ? 1u : 0u; mine = (j == x) ? c : mine; }
        if (sum == G) break;
        __builtin_amdgcn_s_sleep(1);
        if ((++sp & 255u) == 0u) { if (xb_ld(&bar[XB_TMO])) break; if (sp > XB_SPIN_CAP) { atomicAdd(&bar[XB_TMO], 1u); break; } }
    }
    nloc = mine > 0u ? mine : 1u; nx = cnt > 0u ? cnt : 1u;
}

__device__ __forceinline__ void xcd_barrier(const XcdBarrier& b) {
    asm volatile("s_waitcnt vmcnt(0)" ::: "memory");
    __syncthreads();
    if (threadIdx.x == 0) {
        unsigned* bar = b.bar;
        __builtin_amdgcn_s_waitcnt(0);
        unsigned nloc = b.st[0], nx = b.st[1];
        if (nloc == 0u) { xcd_barrier_complete(bar, b.x, nloc, nx); b.st[0] = nloc; b.st[1] = nx; }
        const unsigned old = xb_add(&bar[XB_XSUB(b.x)], 1u);
        const unsigned gen = old / nloc;
        if (old + 1u == (gen + 1u) * nloc) {
            __builtin_amdgcn_fence(__ATOMIC_RELEASE, "agent");
            asm volatile("s_waitcnt vmcnt(0)" ::: "memory");
            const unsigned og = xb_add(&bar[XB_TOP], 1u);
            const unsigned tg = og / nx;
            if (og + 1u == (tg + 1u) * nx) xb_add(&bar[XB_TOPGEN], 1u);
            else XB_SPIN(xb_ld(&bar[XB_TOPGEN]) == tg, bar);
            __builtin_amdgcn_fence(__ATOMIC_ACQUIRE, "agent");
            xb_add(&bar[XB_XGEN(b.x)], 1u);
            asm volatile("s_waitcnt vmcnt(0)" ::: "memory");
        } else {
            XB_SPIN(xb_ld(&bar[XB_XGEN(b.x)]) == gen, bar);
            __builtin_amdgcn_fence(__ATOMIC_ACQUIRE, "agent");
            asm volatile("s_waitcnt vmcnt(0)" ::: "memory");
        }
    }
    __syncthreads();
}

__global__ void __launch_bounds__(NTHREADS) hymba_fwd(Params p) {
    extern __shared__ __attribute__((aligned(16))) unsigned char lds[];
    cg::grid_group grid = cg::this_grid();
    if (threadIdx.x == 0) {
        volatile LAS unsigned long long* q = (volatile LAS unsigned long long*)(lds + LDS_PARAM);
        q[0] = (unsigned long long)p.x_prompt; q[1] = (unsigned long long)p.x_sample; q[2] = (unsigned long long)p.cache_k; q[3] = (unsigned long long)p.cache_v;
        q[4] = (unsigned long long)p.state_conv; q[5] = (unsigned long long)p.state_rglru; q[6] = (unsigned long long)p.meta; q[7] = (unsigned long long)p.rel_bias;
        q[8] = (unsigned long long)p.pre_g; q[9] = (unsigned long long)p.post_g; q[10] = (unsigned long long)p.w_in; q[11] = (unsigned long long)p.conv_w;
        q[12] = (unsigned long long)p.conv_b; q[13] = (unsigned long long)p.gate_r_w; q[14] = (unsigned long long)p.gate_r_b; q[15] = (unsigned long long)p.gate_i_w;
        q[16] = (unsigned long long)p.gate_i_b; q[17] = (unsigned long long)p.rglru_lam; q[18] = (unsigned long long)p.lam_q1; q[19] = (unsigned long long)p.lam_k1;
        q[20] = (unsigned long long)p.lam_q2; q[21] = (unsigned long long)p.lam_k2; q[22] = (unsigned long long)p.subln_g; q[23] = (unsigned long long)p.w_out;
        q[24] = (unsigned long long)p.out; q[25] = (unsigned long long)p.ws;
    }
    if (threadIdx.x < 2) ((volatile LAS unsigned*)(lds + LDS_SLOT + 16))[threadIdx.x] = 0u;
    __syncthreads();
    (void)xcd_barrier_post((unsigned*)(P_WS + WS_BAR), (volatile LAS unsigned*)(lds + LDS_SLOT + 16));
#define GRID_BAR() do { XcdBarrier xb_; xb_.bar = (unsigned*)(P_WS + WS_BAR); xb_.x = xb_xcc_id(); xb_.st = (volatile LAS unsigned*)(lds + LDS_SLOT + 16); xcd_barrier(xb_); } while (0)
    p0_prologue(lds);
    GRID_BAR();
    if (gridDim.x == 0x7fffffffu) grid.sync();
#if DUP_P0
    p0_prologue(lds);
    grid.sync();
#endif
    for (int l = 0; l < DEPTH; ++l) {
        {
            pg8::Gemm gm{(const pg8::bf16_t*)(P_WS + WS_U), (const pg8::bf16_t*)(P_WS + WS_WIN) + (size_t)l * IN_COLS * D_MODEL, TAIL_ROW0, IN_COLS, D_MODEL, D_MODEL};
            pg8::StaticOrder S; S.init(TAIL_ROW0, IN_COLS, (int)gridDim.x, (int)blockIdx.x);
            EpiProj E{(bf16*)(P_WS + WS_PROJ), P_OUT + O_KP + (size_t)l * MP * 1024, P_OUT + O_VP + (size_t)l * MP * 1024, P_OUT + O_KS + (size_t)l * MS * 1024, P_OUT + O_VS + (size_t)l * MS * 1024};
            pg8::gemm_phase<EpiProj, pg8::StaticOrder, true, true>((PG8_LAS unsigned char*)lds, gm, S, E);
#if DUP_G1
            GRID_BAR();
            pg8::gemm_phase<EpiProj, pg8::StaticOrder, true, true>((PG8_LAS unsigned char*)lds, gm, S, E);
#endif
        }
        GRID_BAR();
        if (blockIdx.x < TAIL_TILES) {
            pg8::Gemm gt{(const pg8::bf16_t*)(P_WS + WS_U), (const pg8::bf16_t*)(P_WS + WS_WIN) + (size_t)l * IN_COLS * D_MODEL, MPAD, IN_COLS, D_MODEL, D_MODEL};
            TailWhole St{(int)gridDim.x, (int)blockIdx.x};
            EpiProj Et{(bf16*)(P_WS + WS_PROJ), P_OUT + O_KP + (size_t)l * MP * 1024, P_OUT + O_VP + (size_t)l * MP * 1024, P_OUT + O_KS + (size_t)l * MS * 1024, P_OUT + O_VS + (size_t)l * MS * 1024};
            pg8::gemm_phase<EpiProj, TailWhole, false, true>((PG8_LAS unsigned char*)lds, gt, St, Et);
            tail_signal(lds, l);
        }
        p2_mixers(l, lds);
        GRID_BAR();
#if DUP_SYNC
        GRID_BAR(); GRID_BAR(); GRID_BAR(); GRID_BAR();
#endif
#if DUP_P2
        p2_mixers(l, lds, 1);
        GRID_BAR();
#endif
        {
            const pg8::bf16_t* Wl = (const pg8::bf16_t*)(P_WS + WS_WOUT) + (size_t)l * D_MODEL * D_MODEL;
            {
                pg8::Gemm gm{(const pg8::bf16_t*)(P_WS + WS_YAB), Wl, TAIL_ROW0, D_MODEL, D_MODEL, D_MODEL};
                pg8::StaticOrder S; S.init(TAIL_ROW0, D_MODEL, (int)gridDim.x, (int)blockIdx.x);
                EpiY16 E{(bf16*)(P_WS + WS_Y)};
                pg8::gemm_phase<EpiY16, pg8::StaticOrder, true, true>((PG8_LAS unsigned char*)lds, gm, S, E);
#if DUP_G2
                pg8::gemm_phase<EpiY16, pg8::StaticOrder, true, true>((PG8_LAS unsigned char*)lds, gm, S, E);
#endif
            }
            {
                pg8::Gemm gm{(const pg8::bf16_t*)(P_WS + WS_YAB), Wl, MPAD, D_MODEL, TAIL_K, D_MODEL};
                TailOrder S{(int)gridDim.x, (int)blockIdx.x};
                EpiPart E{(float*)(P_WS + WS_PART)};
                pg8::gemm_phase<EpiPart, TailOrder, false, true>((PG8_LAS unsigned char*)lds, gm, S, E);
#if DUP_G2
                pg8::gemm_phase<EpiPart, TailOrder, false, true>((PG8_LAS unsigned char*)lds, gm, S, E);
#endif
            }
        }
        GRID_BAR();
#if DUP_P4
        p4_rowpass(lds, l, true);
        GRID_BAR();
#endif
        p4_rowpass(lds, l);
        if (l + 1 < DEPTH) GRID_BAR();
    }
}

extern "C" void kernel_launch(void* const* d_in, const int* in_sizes, int n_in, void* d_out, int out_size, void* d_ws, size_t ws_size, hipStream_t stream) {
    static int grid = 0;
    if (grid == 0) {
        if (n_in != 24 || (size_t)out_size != O_END || ws_size < WS_END) { fprintf(stderr, "kernel_launch: unexpected shapes (n_in %d, out %d, ws %zu)\n", n_in, out_size, ws_size); grid = -1; return; }
        int dev = 0, cus = 0, per_cu = 0;
        if (hipGetDevice(&dev) != hipSuccess || hipDeviceGetAttribute(&cus, hipDeviceAttributeMultiprocessorCount, dev) != hipSuccess) { grid = -1; return; }
        if (hipFuncSetAttribute((const void*)hymba_fwd, hipFuncAttributeMaxDynamicSharedMemorySize, LDS_BYTES) != hipSuccess) { fprintf(stderr, "kernel_launch: hipFuncSetAttribute failed\n"); grid = -1; return; }
        if (hipOccupancyMaxActiveBlocksPerMultiprocessor(&per_cu, (const void*)hymba_fwd, NTHREADS, LDS_BYTES) != hipSuccess || per_cu < 1) { fprintf(stderr, "kernel_launch: occupancy query gives %d\n", per_cu); per_cu = 1; (void)hipGetLastError(); }
        grid = cus * 1;
    }
    if (grid < 0) return;
    (void)hipMemsetAsync((char*)d_ws + WS_CTL, 0, CTL_BYTES, stream);
    Params p{};
    const float** pp = (const float**)&p;
    for (int i = 0; i < 24; ++i) pp[i] = (const float*)d_in[i];
    p.out = (float*)d_out; p.ws = (unsigned char*)d_ws;
    void* args[] = {&p};
    hipError_t e = hipLaunchCooperativeKernel((const void*)hymba_fwd, dim3(grid), dim3(NTHREADS), args, LDS_BYTES, stream);
    if (e != hipSuccess) fprintf(stderr, "cooperative launch failed: %s (grid %d)\n", hipGetErrorString(e), grid);
}
```

```cpp
#include <hip/hip_runtime.h>
#include <hip/hip_cooperative_groups.h>
#include <cstdio>
#include <cstdint>
namespace cg = cooperative_groups;
namespace pg8 {
#define PG8_LAS __attribute__((address_space(3)))
typedef unsigned short bf16_t;
typedef short bf16x8 __attribute__((ext_vector_type(8)));
typedef float f32x4 __attribute__((ext_vector_type(4)));
typedef unsigned u32x4 __attribute__((ext_vector_type(4)));
constexpr int BM = 256, BK = 64, HALF = 128, HTB = HALF * BK * 2  , STAGE_BYTES = 8 * HTB, NXCD = 8, WGM = 8;

__host__ __device__ __forceinline__ int lds_byte(int r, int c) { const int st = (r >> 4) * 2 + (c >> 5), rr = r & 15, cc = c & 31, ob = rr * 64 + cc * 2; return st * 1024 + (ob ^ (((ob >> 9) & 1) << 5)); }
__host__ __device__ __forceinline__ void stage_rc(int b, int& R, int& C) { const int st = b / 1024, sb = b % 1024, swz = sb ^ (((sb >> 9) & 1) << 5); R = (st >> 1) * 16 + swz / 64; C = (st & 1) * 32 + (swz % 64) / 2; }
__host__ __device__ __forceinline__ int perm32(int rho) { const int n = rho >> 4, i = rho & 15; return 8 * (i >> 2) + 4 * n + (i & 3); }

struct Unit { int pm, pn, k0; };
struct Gemm { const bf16_t* A; const bf16_t* Bt; int M, N, K, ld; };

struct StaticOrder {
    int nM, nN, nwg, G, c;
    __host__ __device__ void init(int M, int N, int G_, int c_) { nM = M / BM; nN = N / BM; nwg = nM * nN; G = G_; c = c_; }
    __host__ __device__ bool next(int i, Unit& u) const {
        const long L = (long)i * G + c; if (L >= nwg) return false;
        int wgid = (int)L; { const int q = nwg / NXCD, r = nwg % NXCD, xcd = wgid % NXCD, off = wgid / NXCD; wgid = (xcd < r ? xcd * (q + 1) : r * (q + 1) + (xcd - r) * q) + off; }
        const int nig = WGM * nN, gid = wgid / nig, fm = gid * WGM, gsz = (nM - fm) < WGM ? (nM - fm) : WGM;
        u.pm = fm + ((wgid % nig) % gsz); u.pn = (wgid % nig) / gsz; u.k0 = 0; return true;
    }
    __device__ __forceinline__ void a_ready(const Unit&) const {}
    __device__ __forceinline__ void done(const Unit&) const {}
};

__device__ __forceinline__ unsigned cvt_pk_bf16(float lo, float hi) { unsigned r; asm volatile("v_cvt_pk_bf16_f32 %0, %1, %2" : "=v"(r) : "v"(lo), "v"(hi)); return r; }

template <class Epi, class Sched, bool ALIGN_EPI = false, bool SP2 = false>
__device__ __forceinline__ void gemm_phase(PG8_LAS unsigned char* lds, const Gemm g, const Sched& S, const Epi& E) {
    int tid_ = threadIdx.x; asm volatile("" : "+v"(tid_)); const int tid = tid_, wid = __builtin_amdgcn_readfirstlane(tid >> 6), lane = tid & 63, wr = wid >> 2, wc = wid & 3, fr = lane & 15, fq = lane >> 4;
    const int K = g.ld, nt = g.K / BK;
    unsigned voffA[2], voffB[2];
#pragma unroll
    for (int i = 0; i < 2; ++i) { int R, C; stage_rc(tid * 16 + i * 8192, R, C); const int Rb = Epi::PERM ? ((R & ~31) + perm32(R & 31)) : R;
        voffA[i] = (unsigned)(R * K + C) * 2u; voffB[i] = (unsigned)(Rb * K + C) * 2u; }
    const size_t kstep = (size_t)(BK * 2);
    const size_t hstep = (size_t)HALF * K * 2;
    const size_t tstep = 2 * hstep;
    const unsigned ldsw = (unsigned)wid * 1024u;
    const int aoff = lds_byte(wr * 64 + fr, fq * 8), boff = lds_byte(wc * 32 + fr, fq * 8);
#define PG8_SA(b, h) (((b) * 2 + (h)) * HTB)
#define PG8_SB(b, h) ((4 + (b) * 2 + (h)) * HTB)
#define PG8_STAGE(bufoff, gbase, voff) do { _Pragma("unroll") for (int _i = 0; _i < 2; ++_i) \
        __builtin_amdgcn_global_load_lds((const unsigned*)((const char*)(gbase) + (voff)[_i]), (PG8_LAS unsigned*)(lds + (bufoff) + ldsw + _i * 8192), 16, 0, 0); } while (0)
#define PG8_LDA(dst, b, h) do { _Pragma("unroll") for (int m = 0; m < 4; ++m) _Pragma("unroll") for (int k = 0; k < 2; ++k) dst[m][k] = *(const PG8_LAS bf16x8*)(lds + PG8_SA(b, h) + aoff + m * 2048 + k * 1024); } while (0)
#define PG8_LDB(dst, b, h) do { _Pragma("unroll") for (int n = 0; n < 2; ++n) _Pragma("unroll") for (int k = 0; k < 2; ++k) dst[n][k] = *(const PG8_LAS bf16x8*)(lds + PG8_SB(b, h) + boff + n * 2048 + k * 1024); } while (0)
#define PG8_MMA(ai, bj, At, Bt) do { __builtin_amdgcn_s_setprio(1); _Pragma("unroll") for (int m = 0; m < 4; ++m) _Pragma("unroll") for (int n = 0; n < 2; ++n) _Pragma("unroll") for (int k = 0; k < 2; ++k) \
        acc[ai][bj][m][n] = __builtin_amdgcn_mfma_f32_16x16x32_bf16(Bt[n][k], At[m][k], acc[ai][bj][m][n], 0, 0, 0); __builtin_amdgcn_s_setprio(0); } while (0)
#define PG8_WAIT_V(n) asm volatile("s_waitcnt vmcnt(" #n ")" ::: "memory")
#define PG8_WAIT_L(n) asm volatile("s_waitcnt lgkmcnt(" #n ")" ::: "memory")
#define PG8_BAR __builtin_amdgcn_s_barrier()
#define PG8_SCHED __builtin_amdgcn_sched_barrier(0)
    Unit cur, nxt; int ui = 0;
    if (!S.next(0, cur)) return;
    f32x4 acc[2][2][4][2];
#pragma unroll
    for (int a = 0; a < 2; ++a)
#pragma unroll
        for (int b = 0; b < 2; ++b)
#pragma unroll
            for (int m = 0; m < 4; ++m)
#pragma unroll
                for (int n = 0; n < 2; ++n) acc[a][b][m][n] = (f32x4){0.f, 0.f, 0.f, 0.f};
    bf16x8 At[4][2], B0[2][2], B1[2][2];
    const char* cA = (const char*)g.A + (size_t)cur.pm * tstep + (size_t)cur.k0 * 2; const char* cB = (const char*)g.Bt + (size_t)cur.pn * tstep + (size_t)cur.k0 * 2;
    S.a_ready(cur);
    if constexpr (SP2) {
        PG8_STAGE(PG8_SB(0, 0), cB, voffB); PG8_STAGE(PG8_SB(0, 1), cB + hstep, voffB); PG8_STAGE(PG8_SA(0, 0), cA, voffA); PG8_STAGE(PG8_SA(0, 1), cA + hstep, voffA);
        if (wr == 1) PG8_BAR;
        PG8_WAIT_V(2); PG8_BAR;
        PG8_STAGE(PG8_SB(1, 0), cB + kstep, voffB); PG8_STAGE(PG8_SA(1, 0), cA + kstep, voffA); PG8_STAGE(PG8_SB(1, 1), cB + hstep + kstep, voffB);
        PG8_WAIT_V(6); PG8_BAR;
    } else {
        PG8_STAGE(PG8_SB(0, 0), cB, voffB); PG8_STAGE(PG8_SA(0, 0), cA, voffA); PG8_STAGE(PG8_SB(0, 1), cB + hstep, voffB); PG8_STAGE(PG8_SA(0, 1), cA + hstep, voffA);
        if (wr == 1) PG8_BAR;
        PG8_WAIT_V(4); PG8_BAR;
        PG8_STAGE(PG8_SB(1, 0), cB + kstep, voffB); PG8_STAGE(PG8_SA(1, 0), cA + kstep, voffA); PG8_STAGE(PG8_SB(1, 1), cB + hstep + kstep, voffB);
        PG8_WAIT_V(6); PG8_BAR;
    }
    for (;;) {
        const bool has_next = S.next(ui + 1, nxt);
        const char* nA = has_next ? (const char*)g.A + (size_t)nxt.pm * tstep + (size_t)nxt.k0 * 2 : cA; const char* nB = has_next ? (const char*)g.Bt + (size_t)nxt.pn * tstep + (size_t)nxt.k0 * 2 : cB;
        for (int t = 0; t < nt; t += 2) {
            const bool last = (t == nt - 2);
            const char* a1 = cA + (size_t)(t + 1) * kstep;
            const char* a2 = last ? nA : cA + (size_t)(t + 2) * kstep; const char* b2 = last ? nB : cB + (size_t)(t + 2) * kstep;
            const char* a3 = a2 + kstep; const char* b3 = b2 + kstep;
            if (last && has_next) S.a_ready(nxt);
            if constexpr (SP2) {
            PG8_LDB(B0, 0, 0); PG8_LDB(B1, 0, 1); PG8_SCHED; PG8_LDA(At, 0, 0); PG8_STAGE(PG8_SA(1, 1), a1 + hstep, voffA);
            PG8_WAIT_V(8); PG8_WAIT_L(0); PG8_BAR; PG8_MMA(0, 0, At, B0); PG8_MMA(0, 1, At, B1); PG8_BAR; PG8_SCHED;
            PG8_LDA(At, 0, 1); PG8_STAGE(PG8_SB(0, 0), b2, voffB); PG8_STAGE(PG8_SB(0, 1), b2 + hstep, voffB); PG8_STAGE(PG8_SA(0, 0), a2, voffA);
            PG8_WAIT_V(8); PG8_WAIT_L(0); PG8_BAR; PG8_MMA(1, 0, At, B0); PG8_MMA(1, 1, At, B1); PG8_BAR; PG8_SCHED;
            PG8_LDB(B0, 1, 0); PG8_LDB(B1, 1, 1); PG8_SCHED; PG8_LDA(At, 1, 0); PG8_STAGE(PG8_SA(0, 1), a2 + hstep, voffA);
            PG8_WAIT_V(8); PG8_WAIT_L(0); PG8_BAR; PG8_MMA(0, 0, At, B0); PG8_MMA(0, 1, At, B1); PG8_BAR; PG8_SCHED;
            PG8_LDA(At, 1, 1); PG8_STAGE(PG8_SB(1, 0), b3, voffB); PG8_STAGE(PG8_SB(1, 1), b3 + hstep, voffB); PG8_STAGE(PG8_SA(1, 0), a3, voffA);
            PG8_WAIT_V(8); PG8_WAIT_L(0); PG8_BAR; PG8_MMA(1, 0, At, B0); PG8_MMA(1, 1, At, B1); PG8_BAR; PG8_SCHED;
            } else {
            PG8_LDB(B0, 0, 0); PG8_SCHED; PG8_LDA(At, 0, 0); PG8_STAGE(PG8_SA(1, 1), a1 + hstep, voffA);
            PG8_WAIT_L(8); PG8_BAR; PG8_WAIT_L(0); PG8_MMA(0, 0, At, B0); PG8_BAR; PG8_SCHED;
            PG8_LDB(B1, 0, 1); PG8_STAGE(PG8_SB(0, 0), b2, voffB);
            PG8_BAR; PG8_WAIT_L(0); PG8_MMA(0, 1, At, B1); PG8_BAR;
            PG8_LDA(At, 0, 1); PG8_STAGE(PG8_SA(0, 0), a2, voffA);
            PG8_BAR; PG8_WAIT_L(0); PG8_MMA(1, 0, At, B0); PG8_BAR; PG8_SCHED;
            PG8_STAGE(PG8_SB(0, 1), b2 + hstep, voffB);
            PG8_WAIT_V(6); PG8_BAR; PG8_MMA(1, 1, At, B1); PG8_BAR;
            PG8_LDB(B0, 1, 0); PG8_SCHED; PG8_LDA(At, 1, 0); PG8_STAGE(PG8_SA(0, 1), a2 + hstep, voffA);
            PG8_WAIT_L(8); PG8_BAR; PG8_WAIT_L(0); PG8_MMA(0, 0, At, B0); PG8_BAR; PG8_SCHED;
            PG8_LDB(B1, 1, 1); PG8_STAGE(PG8_SB(1, 0), b3, voffB);
            PG8_BAR; PG8_WAIT_L(0); PG8_MMA(0, 1, At, B1); PG8_BAR;
            PG8_LDA(At, 1, 1); PG8_STAGE(PG8_SA(1, 0), a3, voffA);
            PG8_BAR; PG8_WAIT_L(0); PG8_MMA(1, 0, At, B0); PG8_BAR; PG8_SCHED;
            PG8_STAGE(PG8_SB(1, 1), b3 + hstep, voffB);
            PG8_WAIT_V(6); PG8_BAR; PG8_MMA(1, 1, At, B1); PG8_BAR;
            }
        }
        if constexpr (ALIGN_EPI) { if (wr == 0) PG8_BAR; }
        if constexpr (!Epi::AFTER_DRAIN) { E(acc, cur, wr, wc, fr, fq); S.done(cur); }
        if (!has_next) break;
#pragma unroll
        for (int a = 0; a < 2; ++a)
#pragma unroll
            for (int b = 0; b < 2; ++b)
#pragma unroll
                for (int m = 0; m < 4; ++m)
#pragma unroll
                    for (int n = 0; n < 2; ++n) acc[a][b][m][n] = (f32x4){0.f, 0.f, 0.f, 0.f};
        cur = nxt; cA = nA; cB = nB; ++ui;
        if constexpr (ALIGN_EPI) { if (wr == 1) PG8_BAR; }
    }
    PG8_WAIT_V(0);
    if constexpr (!ALIGN_EPI) { if (wr == 0) PG8_BAR; }
    PG8_BAR;
    if constexpr (Epi::AFTER_DRAIN) { E.fused(acc, cur, wr, wc, fr, fq, lds, wid, lane); S.done(cur); }
#undef PG8_SA
#undef PG8_SB
#undef PG8_STAGE
#undef PG8_LDA
#undef PG8_LDB
#undef PG8_MMA
#undef PG8_WAIT_V
#undef PG8_WAIT_L
#undef PG8_BAR
#undef PG8_SCHED
}
}

#ifndef DUP_P0
#define DUP_P0 0
#endif
#ifndef DUP_P2
#define DUP_P2 0
#endif
#ifndef DUP_G1
#define DUP_G1 0
#endif
#ifndef DUP_RG
#define DUP_RG 0
#endif
#ifndef DUP_AT
#define DUP_AT 0
#endif
#ifndef DUP_SYNC
#define DUP_SYNC 0
#endif
#ifndef DUP_P4
#define DUP_P4 0
#endif
#ifndef DUP_LOOP
#define DUP_LOOP 0
#endif
#ifndef DUP_EXP
#define DUP_EXP 0
#endif
#ifndef DUP_QK
#define DUP_QK 0
#endif
#ifndef DUP_G2
#define DUP_G2 0
#endif
#define LAS __attribute__((address_space(3)))
typedef unsigned short bf16;
typedef short bf16x8 __attribute__((ext_vector_type(8)));
typedef short s16x4 __attribute__((ext_vector_type(4)));
typedef float f32x4 __attribute__((ext_vector_type(4)));
typedef unsigned u32x4 __attribute__((ext_vector_type(4)));
typedef unsigned u32x2 __attribute__((ext_vector_type(2)));

constexpr int D_MODEL = 2048, NBATCH = 8, SEQ = 2048, DEPTH = 4, DEC_T = 32, PAST = 2048;
constexpr int NMETA = 16, LP = NMETA + SEQ, MP = NBATCH * LP, MS = NBATCH * DEC_T, MTOT = MP + MS, MPAD = 16896;
constexpr int D_A = 1024, NH = 8, IN_COLS = 6144;
constexpr int C_XA = 0, C_GA = 1024, C_Q = 2048, C_K = 3072, C_V = 4096, C_GB = 5120;
constexpr float EPS = 1e-6f;
constexpr float LOG2E = 1.4426950408889634f;
constexpr int BT_N = 2176, BT_OFF = 2080, BT_LDS = 2304;

constexpr size_t O_YP = 0, O_YS = O_YP + (size_t)NBATCH * SEQ * D_MODEL, O_KP = O_YS + (size_t)MS * D_MODEL,
                 O_VP = O_KP + (size_t)DEPTH * MP * 1024, O_CP = O_VP + (size_t)DEPTH * MP * 1024, O_RP = O_CP + (size_t)DEPTH * NBATCH * 3 * D_A,
                 O_KS = O_RP + (size_t)DEPTH * NBATCH * D_A, O_VS = O_KS + (size_t)DEPTH * MS * 1024, O_CS = O_VS + (size_t)DEPTH * MS * 1024,
                 O_RS = O_CS + (size_t)DEPTH * NBATCH * 3 * D_A, O_END = O_RS + (size_t)DEPTH * NBATCH * D_A;

constexpr size_t MiB = 1u << 20;
constexpr size_t WS_CTL = 0, CTL_BYTES = 65536, WS_BAR = 16384, WS_LAM = 65536, WS_BT = 69632;
constexpr size_t WS_WIN = 1 * MiB, WS_WOUT = 97 * MiB, WS_X = 129 * MiB, WS_U = 261 * MiB, WS_PROJ = 327 * MiB, WS_YAB = 525 * MiB, WS_Y = 591 * MiB, WS_END = 723 * MiB;
static_assert(WS_WIN + (size_t)DEPTH * IN_COLS * D_MODEL * 2 <= WS_WOUT && WS_WOUT + (size_t)DEPTH * D_MODEL * D_MODEL * 2 <= WS_X && WS_X + (size_t)MPAD * D_MODEL * 4 <= WS_U &&
              WS_U + (size_t)MPAD * D_MODEL * 2 <= WS_PROJ && WS_PROJ + (size_t)MPAD * IN_COLS * 2 <= WS_YAB && WS_YAB + (size_t)MPAD * D_MODEL * 2 <= WS_Y && WS_Y + (size_t)MPAD * D_MODEL * 4 <= WS_END, "ws map");

constexpr size_t WS_PART = WS_Y + 66 * MiB;
static_assert(WS_PART + (size_t)16 * 512 * 2048 * 4 <= WS_END && (size_t)4 * 512 * 6144 * 4 <= (size_t)64 * MiB, "ws map 2");
constexpr int LDS_BYTES = 135168;
constexpr int LDS_SLOT = 131072;
constexpr int LDS_PARAM = 131072 + 64;
constexpr int NTHREADS = 512;

struct Params {
    const float *x_prompt, *x_sample, *cache_k, *cache_v, *state_conv, *state_rglru, *meta, *rel_bias, *pre_g, *post_g, *w_in, *conv_w, *conv_b,
        *gate_r_w, *gate_r_b, *gate_i_w, *gate_i_b, *rglru_lam, *lam_q1, *lam_k1, *lam_q2, *lam_k2, *subln_g, *w_out;
    float* out; unsigned char* ws;
};
__device__ __forceinline__ const float* ldp(const unsigned char* lds, int off) {
    const LAS unsigned* q = (const LAS unsigned*)(lds + LDS_PARAM + off);
    const unsigned lo = __builtin_amdgcn_readfirstlane(q[0]), hi = __builtin_amdgcn_readfirstlane(q[1]);
    return (const float*)(const __attribute__((address_space(1))) float*)(((unsigned long long)hi << 32) | (unsigned long long)lo);
}
static_assert(offsetof(Params, ws) == 200 && sizeof(Params) == 208, "Params layout");
#define PP(name) ldp(lds, (int)offsetof(Params, name))
#define P_OUT ((float*)ldp(lds, (int)offsetof(Params, out)))
#define P_WS ((unsigned char*)ldp(lds, (int)offsetof(Params, ws)))

__device__ __forceinline__ unsigned f2bf(float f) { unsigned u = __float_as_uint(f); return (u + 0x7fffu + ((u >> 16) & 1u)) >> 16; }
__device__ __forceinline__ unsigned pk2(float lo, float hi) { unsigned r; asm("v_cvt_pk_bf16_f32 %0, %1, %2" : "=v"(r) : "v"(lo), "v"(hi)); return r; }
__device__ __forceinline__ float bflo(unsigned u) { return __uint_as_float(u << 16); }
__device__ __forceinline__ float bfhi(unsigned u) { return __uint_as_float(u & 0xffff0000u); }
__device__ __forceinline__ float wave_sum(float v) {
#pragma unroll
    for (int o = 1; o < 64; o <<= 1) v += __shfl_xor(v, o);
    return v;
}
__device__ __forceinline__ float sigmoidf_(float x) { return __builtin_amdgcn_rcpf(1.f + __expf(-x)); }
__device__ __forceinline__ float siluf_(float x) { return x * __builtin_amdgcn_rcpf(1.f + __expf(-x)); }
__device__ __forceinline__ int opaque_tid() { int t = threadIdx.x; asm volatile("" : "+v"(t)); return t; }
#define LDS_BARRIER() asm volatile("s_waitcnt lgkmcnt(0)\n\ts_barrier" ::: "memory")
#define MFMA16(a, b, c) __builtin_amdgcn_mfma_f32_16x16x32_bf16((a), (b), (c), 0, 0, 0)
typedef short v4i16_t __attribute__((ext_vector_type(4)));
__device__ __forceinline__ s16x4 vtr(const unsigned char* p) { return __builtin_bit_cast(s16x4, __builtin_amdgcn_ds_read_tr16_b64_v4i16((LAS v4i16_t*)p)); }

struct EpiProj {
    static constexpr bool PERM = true, AFTER_DRAIN = false;
    bf16* P; float *kp, *vp, *ks, *vs;
    __device__ __forceinline__ void operator()(const f32x4 (&acc)[2][2][4][2], const pg8::Unit& u, int wr, int wc, int fr, int fq) const {
        const int row0 = u.pm * 256 + wr * 64 + fr, col0 = u.pn * 256 + wc * 32 + 8 * fq;
        const int kind = (u.pn >= 12 && u.pn < 16) ? 1 : ((u.pn >= 16 && u.pn < 20) ? 2 : 0);
#pragma unroll
        for (int ai = 0; ai < 2; ++ai)
#pragma unroll
            for (int m = 0; m < 4; ++m) {
                const int row = row0 + ai * 128 + m * 16;
                bf16* rowp = P + (size_t)row * IN_COLS + col0;
                float* fo = nullptr;
                if (kind != 0 && row < MTOT) {
                    if (kind == 1) fo = (row < MP ? kp + (size_t)row * 1024 : ks + (size_t)(row - MP) * 1024) + (col0 - C_K);
                    else           fo = (row < MP ? vp + (size_t)row * 1024 : vs + (size_t)(row - MP) * 1024) + (col0 - C_V);
                }
#pragma unroll
                for (int bj = 0; bj < 2; ++bj) {
                    const f32x4 v0 = acc[ai][bj][m][0], v1 = acc[ai][bj][m][1];
                    u32x4 wv; wv.x = pk2(v0[0], v0[1]); wv.y = pk2(v0[2], v0[3]); wv.z = pk2(v1[0], v1[1]); wv.w = pk2(v1[2], v1[3]);
                    *(u32x4*)(rowp + bj * 128) = wv;
                    if (fo) { *(f32x4*)(fo + bj * 128) = v0; *(f32x4*)(fo + bj * 128 + 4) = v1; }
                }
            }
    }
};
struct EpiY16 {
    static constexpr bool PERM = true, AFTER_DRAIN = false;
    bf16* Y;
    __device__ __forceinline__ void operator()(const f32x4 (&acc)[2][2][4][2], const pg8::Unit& u, int wr, int wc, int fr, int fq) const {
        const int row0 = u.pm * 256 + wr * 64 + fr, col0 = u.pn * 256 + wc * 32 + 8 * fq;
#pragma unroll
        for (int ai = 0; ai < 2; ++ai)
#pragma unroll
            for (int m = 0; m < 4; ++m) {
                bf16* rowp = Y + (size_t)(row0 + ai * 128 + m * 16) * D_MODEL + col0;
#pragma unroll
                for (int bj = 0; bj < 2; ++bj) { const f32x4 v0 = acc[ai][bj][m][0], v1 = acc[ai][bj][m][1];
                    u32x4 wv; wv.x = pk2(v0[0], v0[1]); wv.y = pk2(v0[2], v0[3]); wv.z = pk2(v1[0], v1[1]); wv.w = pk2(v1[2], v1[3]);
                    *(u32x4*)(rowp + bj * 128) = wv; }
            }
    }
};
constexpr int TAIL_ROW0 = 16384, TAIL_ROWS = 512, TAIL_KP = 16, TAIL_K = D_MODEL / TAIL_KP;
struct TailOrder {
    int G, c;
    __device__ __forceinline__ bool next(int i, pg8::Unit& u) const { const int L = i * G + c; if (L >= 16 * TAIL_KP) return false;
        const int tile = L / TAIL_KP, kp = L % TAIL_KP; u.pm = TAIL_ROW0 / 256 + (tile >> 3); u.pn = tile & 7; u.k0 = kp * TAIL_K; return true; }
    __device__ __forceinline__ void a_ready(const pg8::Unit&) const {}
    __device__ __forceinline__ void done(const pg8::Unit&) const {}
};
struct EpiPart {
    static constexpr bool PERM = true, AFTER_DRAIN = false;
    float* PART;
    __device__ __forceinline__ void operator()(const f32x4 (&acc)[2][2][4][2], const pg8::Unit& u, int wr, int wc, int fr, int fq) const {
        const int row0 = u.pm * 256 - TAIL_ROW0 + wr * 64 + fr, col0 = u.pn * 256 + wc * 32 + 8 * fq;
        float* base = PART + (size_t)(u.k0 / TAIL_K) * TAIL_ROWS * D_MODEL;
#pragma unroll
        for (int ai = 0; ai < 2; ++ai)
#pragma unroll
            for (int m = 0; m < 4; ++m) {
                float* rowp = base + (size_t)(row0 + ai * 128 + m * 16) * D_MODEL + col0;
#pragma unroll
                for (int bj = 0; bj < 2; ++bj) { *(f32x4*)(rowp + bj * 128) = acc[ai][bj][m][0]; *(f32x4*)(rowp + bj * 128 + 4) = acc[ai][bj][m][1]; }
            }
    }
};
constexpr int T1_KP = 4, T1_K = D_MODEL / T1_KP;
struct TailWhole {
    int G, c;
    __device__ __forceinline__ bool next(int i, pg8::Unit& u) const { const int L = i * G + c; if (L >= 48) return false; u.pm = TAIL_ROW0 / 256 + L / 24; u.pn = L % 24; u.k0 = 0; return true; }
    __device__ __forceinline__ void a_ready(const pg8::Unit&) const {}
    __device__ __forceinline__ void done(const pg8::Unit&) const {}
};
struct Tail1Order {
    int G, c;
    __device__ __forceinline__ bool next(int i, pg8::Unit& u) const { const int L = i * G + c; if (L >= 48 * T1_KP) return false;
        const int tile = L / T1_KP, kp = L % T1_KP; u.pm = TAIL_ROW0 / 256 + tile / 24; u.pn = tile % 24; u.k0 = kp * T1_K; return true; }
    __device__ __forceinline__ void a_ready(const pg8::Unit&) const {}
    __device__ __forceinline__ void done(const pg8::Unit&) const {}
};
struct EpiPart1 {
    static constexpr bool PERM = true, AFTER_DRAIN = false;
    float* PART;
    __device__ __forceinline__ void operator()(const f32x4 (&acc)[2][2][4][2], const pg8::Unit& u, int wr, int wc, int fr, int fq) const {
        const int row0 = u.pm * 256 - TAIL_ROW0 + wr * 64 + fr, col0 = u.pn * 256 + wc * 32 + 8 * fq;
        float* base = PART + (size_t)(u.k0 / T1_K) * TAIL_ROWS * IN_COLS;
#pragma unroll
        for (int ai = 0; ai < 2; ++ai)
#pragma unroll
            for (int m = 0; m < 4; ++m) {
                float* rowp = base + (size_t)(row0 + ai * 128 + m * 16) * IN_COLS + col0;
#pragma unroll
                for (int bj = 0; bj < 2; ++bj) { *(f32x4*)(rowp + bj * 128) = acc[ai][bj][m][0]; *(f32x4*)(rowp + bj * 128 + 4) = acc[ai][bj][m][1]; }
            }
    }
};
__device__ __forceinline__ void p1_tail_reduce(unsigned char* lds, int l) {
    const int tid = opaque_tid();
    const float* PART = (const float*)(P_WS + WS_PART); bf16* PROJ = (bf16*)(P_WS + WS_PROJ);
    float* kp = P_OUT + O_KP + (size_t)l * MP * 1024; float* vp = P_OUT + O_VP + (size_t)l * MP * 1024;
    float* ks = P_OUT + O_KS + (size_t)l * MS * 1024; float* vs = P_OUT + O_VS + (size_t)l * MS * 1024;
    constexpr int NIT = (MTOT - TAIL_ROW0) * (IN_COLS / 8);
    for (int it = blockIdx.x * NTHREADS + tid; it < NIT; it += gridDim.x * NTHREADS) {
        const int rl = it / (IN_COLS / 8), c = (it % (IN_COLS / 8)) * 8, row = TAIL_ROW0 + rl;
        const float* p0 = PART + (size_t)rl * IN_COLS + c;
        f32x4 a[T1_KP], b[T1_KP];
#pragma unroll
        for (int k = 0; k < T1_KP; ++k) { a[k] = *(const f32x4*)(p0 + (size_t)k * TAIL_ROWS * IN_COLS); b[k] = *(const f32x4*)(p0 + (size_t)k * TAIL_ROWS * IN_COLS + 4); }
        const f32x4 v0 = (a[0] + a[1]) + (a[2] + a[3]), v1 = (b[0] + b[1]) + (b[2] + b[3]);
        u32x4 wv; wv.x = pk2(v0[0], v0[1]); wv.y = pk2(v0[2], v0[3]); wv.z = pk2(v1[0], v1[1]); wv.w = pk2(v1[2], v1[3]);
        *(u32x4*)(PROJ + (size_t)row * IN_COLS + c) = wv;
        if (c >= C_K && c < C_GB) {
            float* fo = (c < C_V) ? ((row < MP ? kp + (size_t)row * 1024 : ks + (size_t)(row - MP) * 1024) + (c - C_K))
                                  : ((row < MP ? vp + (size_t)row * 1024 : vs + (size_t)(row - MP) * 1024) + (c - C_V));
            *(f32x4*)fo = v0; *(f32x4*)(fo + 4) = v1;
        }
    }
}
struct EpiF32 {
    static constexpr bool PERM = true, AFTER_DRAIN = false;
    float* Y;
    __device__ __forceinline__ void operator()(const f32x4 (&acc)[2][2][4][2], const pg8::Unit& u, int wr, int wc, int fr, int fq) const {
        const int row0 = u.pm * 256 + wr * 64 + fr, col0 = u.pn * 256 + wc * 32 + 8 * fq;
#pragma unroll
        for (int ai = 0; ai < 2; ++ai)
#pragma unroll
            for (int m = 0; m < 4; ++m) {
                float* rowp = Y + (size_t)(row0 + ai * 128 + m * 16) * D_MODEL + col0;
#pragma unroll
                for (int bj = 0; bj < 2; ++bj) { *(f32x4*)(rowp + bj * 128) = acc[ai][bj][m][0]; *(f32x4*)(rowp + bj * 128 + 4) = acc[ai][bj][m][1]; }
            }
    }
};

__device__ __forceinline__ void p0_transpose_item(const float* W, int K, int N, bf16* WT, float* scr, int item, int lane) {
    const int nblk = N / 32, kb = item / nblk, nb = item % nblk, k0 = 64 * kb, n0 = 32 * nb;
#pragma unroll 8
    for (int i = 0; i < 32; ++i) { const int kk = 2 * i + (lane >> 5); scr[kk * 33 + (lane & 31)] = W[(size_t)(k0 + kk) * N + n0 + (lane & 31)]; }
    asm volatile("s_waitcnt lgkmcnt(0)" ::: "memory");
    const int c = lane & 7;
#pragma unroll
    for (int j = 0; j < 4; ++j) { const int n = (lane >> 3) + 8 * j; const float* s = scr + (8 * c) * 33 + n;
        u32x4 o; o.x = pk2(s[0 * 33], s[1 * 33]); o.y = pk2(s[2 * 33], s[3 * 33]); o.z = pk2(s[4 * 33], s[5 * 33]); o.w = pk2(s[6 * 33], s[7 * 33]);
        *(u32x4*)(WT + (size_t)(n0 + n) * K + k0 + 8 * c) = o; }
    asm volatile("s_waitcnt lgkmcnt(0)" ::: "memory");
}

__device__ __forceinline__ int rel_bucket(int rel) {
    const int n = rel < 0 ? -rel : rel;
    int ret = rel > 0 ? 16 : 0;
    if (n < 8) return ret + n;
    const float nf = (float)n;
    int large = 8 + (int)(logf(nf / 8.0f) / 4.852030263919617f * 8.0f);
    large = large < 15 ? large : 15;
    return ret + large;
}

__device__ __forceinline__ void norm_to_u(const f32x4 (&v)[8], const float* g, bf16* urow, int lane) {
    float ss = 0.f;
#pragma unroll
    for (int j = 0; j < 8; ++j) ss += (v[j][0] * v[j][0] + v[j][1] * v[j][1]) + (v[j][2] * v[j][2] + v[j][3] * v[j][3]);
    const float rs = rsqrtf(wave_sum(ss) * (1.f / D_MODEL) + EPS);
#pragma unroll
    for (int j = 0; j < 8; ++j) {
        const f32x4 gg = *(const f32x4*)(g + 4 * lane + 256 * j);
        u32x2 o; o.x = pk2(v[j][0] * rs * gg[0], v[j][1] * rs * gg[1]); o.y = pk2(v[j][2] * rs * gg[2], v[j][3] * rs * gg[3]);
        *(u32x2*)(urow + 4 * lane + 256 * j) = o;
    }
}

__device__ __forceinline__ void p0_prologue(unsigned char* lds) {
    const int tid = opaque_tid(), lane = tid & 63, wave = tid >> 6;
    const int gw = blockIdx.x * 8 + wave, NGW = gridDim.x * 8;
    float* scr = (float*)(lds + wave * 16384);
    bf16* WinT = (bf16*)(P_WS + WS_WIN); bf16* WoutT = (bf16*)(P_WS + WS_WOUT);
    constexpr int I_IN = (D_MODEL / 64) * (IN_COLS / 32), I_OUT = (D_MODEL / 64) * (D_MODEL / 32);
    for (int it = gw; it < DEPTH * (I_IN + I_OUT); it += NGW) {
        if (it < DEPTH * I_IN) { const int l = it / I_IN, r = it % I_IN;
            p0_transpose_item(PP(w_in) + (size_t)l * D_MODEL * IN_COLS, D_MODEL, IN_COLS, WinT + (size_t)l * IN_COLS * D_MODEL, scr, r, lane); }
        else { const int it2 = it - DEPTH * I_IN, l = it2 / I_OUT, r = it2 % I_OUT;
            p0_transpose_item(PP(w_out) + (size_t)l * D_MODEL * D_MODEL, D_MODEL, D_MODEL, WoutT + (size_t)l * D_MODEL * D_MODEL, scr, r, lane); }
    }
    __syncthreads();
    *(f32x4*)(lds + 16 * tid) = *(const f32x4*)(PP(pre_g) + 4 * tid);
    __syncthreads();
    bf16* U = (bf16*)(P_WS + WS_U); bf16* YAB = (bf16*)(P_WS + WS_YAB);
    for (int r = gw; r < MPAD; r += NGW) {
        if (r >= MTOT) {
#pragma unroll
            for (int j = 0; j < 8; ++j) { *(u32x2*)(U + (size_t)r * D_MODEL + 4 * lane + 256 * j) = (u32x2){0u, 0u}; *(u32x2*)(YAB + (size_t)r * D_MODEL + 4 * lane + 256 * j) = (u32x2){0u, 0u}; }
            continue;
        }
        const float* src;
        if (r < MP) { const int b = r / LP, pos = r % LP; src = pos < NMETA ? PP(meta) + (size_t)pos * D_MODEL : PP(x_prompt) + ((size_t)b * SEQ + (pos - NMETA)) * D_MODEL; }
        else src = PP(x_sample) + (size_t)(r - MP) * D_MODEL;
        f32x4 v[8];
#pragma unroll
        for (int j = 0; j < 8; ++j) v[j] = *(const f32x4*)(src + 4 * lane + 256 * j);
        norm_to_u(v, (const float*)lds, U + (size_t)r * D_MODEL, lane);
    }
    float* BT = (float*)(P_WS + WS_BT);
    for (int i = blockIdx.x * NTHREADS + tid; i < NH * BT_N; i += gridDim.x * NTHREADS) {
        const int h = i / BT_N, idx = i % BT_N;
        BT[i] = PP(rel_bias)[rel_bucket(idx - BT_OFF) * NH + h] * LOG2E;
    }
    if (blockIdx.x == 0 && wave < DEPTH) {
        const int l = wave;
        const float a = wave_sum(PP(lam_q1)[l * 64 + lane] * PP(lam_k1)[l * 64 + lane]);
        const float b = wave_sum(PP(lam_q2)[l * 64 + lane] * PP(lam_k2)[l * 64 + lane]);
        const float lam_init = 0.8f - 0.6f * expf(-0.3f * (float)l);
        if (lane == 0) ((float*)(P_WS + WS_LAM))[l] = expf(a) - expf(b) + lam_init;
    }
}

template <bool FIRST, bool LAST>
__device__ __forceinline__ void p4_body(unsigned char* lds, int l, const bool dry) {
    const int tid = opaque_tid(), lane = tid & 63, wave = __builtin_amdgcn_readfirstlane(tid >> 6);
    const int gw = wave * gridDim.x + blockIdx.x, NGW = gridDim.x * 8;
    const float* GP = (const float*)lds; const float* GN = (const float*)(lds + 8192);
    const bf16* Xr = (const bf16*)(P_WS + WS_X); const bf16* Y = (const bf16*)(P_WS + WS_Y); const float* PART = (const float*)(P_WS + WS_PART);
    bf16* Xw = (bf16*)(P_WS + (dry ? WS_PROJ : WS_X)); bf16* U = (bf16*)(P_WS + (dry ? WS_PROJ + 66 * MiB : WS_U));
    float* OUT = P_OUT; float* DRY = (float*)(P_WS + WS_PROJ);
    const float* xin_p = PP(x_prompt); const float* xin_s = PP(x_sample); const float* xin_m = PP(meta);
    for (int it = 0; ; ++it) {
        const int r0 = gw + 2 * it * NGW;
        if (r0 >= MTOT) break;
        int rr[2]; rr[0] = r0; rr[1] = r0 + NGW; const bool has2 = rr[1] < MTOT; if (!has2) rr[1] = r0;
        f32x4 y[2][8], x[2][8];
#pragma unroll
        for (int q = 0; q < 2; ++q) {
            const int r = rr[q];
            if (r < TAIL_ROW0) {
#pragma unroll
                for (int j = 0; j < 8; ++j) { const u32x2 raw = *(const u32x2*)(Y + (size_t)r * D_MODEL + 4 * lane + 256 * j); y[q][j] = (f32x4){bflo(raw.x), bfhi(raw.x), bflo(raw.y), bfhi(raw.y)}; }
            } else {
                const float* pr = PART + (size_t)(r - TAIL_ROW0) * D_MODEL + 4 * lane;
#pragma unroll
                for (int j = 0; j < 8; ++j) y[q][j] = *(const f32x4*)(pr + 256 * j);
#pragma unroll 3
                for (int kp = 1; kp < TAIL_KP; ++kp) {
                    f32x4 t[8];
#pragma unroll
                    for (int j = 0; j < 8; ++j) t[j] = *(const f32x4*)(pr + (size_t)kp * TAIL_ROWS * D_MODEL + 256 * j);
#pragma unroll
                    for (int j = 0; j < 8; ++j) y[q][j] = y[q][j] + t[j];
                }
            }
            if (FIRST) {
                const float* src;
                if (r < MP) { const int b = r / LP, pos = r % LP; src = pos < NMETA ? xin_m + (size_t)pos * D_MODEL : xin_p + ((size_t)b * SEQ + (pos - NMETA)) * D_MODEL; }
                else src = xin_s + (size_t)(r - MP) * D_MODEL;
#pragma unroll
                for (int j = 0; j < 8; ++j) x[q][j] = *(const f32x4*)(src + 4 * lane + 256 * j);
            } else {
#pragma unroll
                for (int j = 0; j < 8; ++j) { const u32x2 raw = *(const u32x2*)(Xr + (size_t)r * D_MODEL + 4 * lane + 256 * j); x[q][j] = (f32x4){bflo(raw.x), bfhi(raw.x), bflo(raw.y), bfhi(raw.y)}; }
            }
        }
#pragma unroll
        for (int q = 0; q < 2; ++q) {
            const int r = rr[q];
            if (q == 1 && !has2) break;
            float ss = 0.f;
#pragma unroll
            for (int j = 0; j < 8; ++j) ss += (y[q][j][0] * y[q][j][0] + y[q][j][1] * y[q][j][1]) + (y[q][j][2] * y[q][j][2] + y[q][j][3] * y[q][j][3]);
            const float rs = rsqrtf(wave_sum(ss) * (1.f / D_MODEL) + EPS);
#pragma unroll
            for (int j = 0; j < 8; ++j) { const f32x4 gg = *(const f32x4*)(GP + 4 * lane + 256 * j); x[q][j] = x[q][j] + y[q][j] * rs * gg; }
            if (!LAST) {
                float s2 = 0.f;
#pragma unroll
                for (int j = 0; j < 8; ++j) s2 += (x[q][j][0] * x[q][j][0] + x[q][j][1] * x[q][j][1]) + (x[q][j][2] * x[q][j][2] + x[q][j][3] * x[q][j][3]);
                const float r2 = rsqrtf(wave_sum(s2) * (1.f / D_MODEL) + EPS);
#pragma unroll
                for (int j = 0; j < 8; ++j) {
                    const f32x4 gn = *(const f32x4*)(GN + 4 * lane + 256 * j);
                    u32x2 o; o.x = pk2(x[q][j][0], x[q][j][1]); o.y = pk2(x[q][j][2], x[q][j][3]); *(u32x2*)(Xw + (size_t)r * D_MODEL + 4 * lane + 256 * j) = o;
                    u32x2 u; u.x = pk2(x[q][j][0] * r2 * gn[0], x[q][j][1] * r2 * gn[1]); u.y = pk2(x[q][j][2] * r2 * gn[2], x[q][j][3] * r2 * gn[3]); *(u32x2*)(U + (size_t)r * D_MODEL + 4 * lane + 256 * j) = u;
                }
            } else {
                float* dst = nullptr;
                if (r < MP) { const int b = r / LP, pos = r % LP; if (pos >= NMETA) dst = OUT + O_YP + ((size_t)b * SEQ + (pos - NMETA)) * D_MODEL; }
                else dst = OUT + O_YS + (size_t)(r - MP) * D_MODEL;
                if (dry) dst = DRY + (size_t)r * D_MODEL;
                if (dst) {
#pragma unroll
                    for (int j = 0; j < 8; ++j) *(f32x4*)(dst + 4 * lane + 256 * j) = x[q][j];
                }
            }
        }
    }
}
__device__ __forceinline__ void p4_rowpass(unsigned char* lds, int l, const bool dry = false) {
    {
        const int tid = opaque_tid();
        const float* pg = PP(post_g) + (size_t)l * D_MODEL; const float* ng = PP(pre_g) + (size_t)(l + 1 < DEPTH ? l + 1 : l) * D_MODEL;
        *(f32x4*)(lds + 16 * tid) = *(const f32x4*)(pg + 4 * tid); *(f32x4*)(lds + 8192 + 16 * tid) = *(const f32x4*)(ng + 4 * tid);
        __syncthreads();
    }
    if (l == 0) p4_body<true, false>(lds, l, dry);
    else if (l == DEPTH - 1) p4_body<false, true>(lds, l, dry);
    else p4_body<false, false>(lds, l, dry);
}

constexpr int RG_XAB = 0, RG_XCB = 16896, RG_WT = 35328, RG_AL = 53760, RG_BL = 86528, RG_SA = 119296, RG_SH = 121344, RG_HC = 123392, RG_SP = 123904, RG_BR = 124160, RG_BI = 124416, RG_CW = 124672;
static_assert(RG_CW + 1280 <= 131072, "rglru LDS map");
__device__ __forceinline__ void rglru_unit(int l, int b, int n, const bool SAMPLE, unsigned char* lds) {
    const int tid = opaque_tid(), lane = tid & 63, w = __builtin_amdgcn_readfirstlane(tid >> 6), c16 = lane & 15, g = lane >> 4;
    const int T = SAMPLE ? DEC_T : LP;
    const int rowbase = SAMPLE ? MP + b * DEC_T : b * LP;
    const int c0 = n * 64;
    const bf16* PROJ = (const bf16*)(P_WS + WS_PROJ); bf16* YAB = (bf16*)(P_WS + WS_YAB);
    unsigned char* XAB = lds + RG_XAB; unsigned char* XCB = lds + RG_XCB; unsigned char* WT = lds + RG_WT;
    float* AL = (float*)(lds + RG_AL); float* BL = (float*)(lds + RG_BL); float* SA = (float*)(lds + RG_SA); float* SH = (float*)(lds + RG_SH); float* HC = (float*)(lds + RG_HC);
    float* SP = (float*)(lds + RG_SP); float* BR = (float*)(lds + RG_BR); float* BI = (float*)(lds + RG_BI); float* CW = (float*)(lds + RG_CW);
    {
        const float* wr = PP(gate_r_w) + ((size_t)l * 16 + n) * 4096; const float* wi = PP(gate_i_w) + ((size_t)l * 16 + n) * 4096;
#pragma unroll
        for (int i = 0; i < 8; ++i) { const int e = tid + 512 * i, c = e >> 6, d = e & 63;
            *(bf16*)(WT + d * 144 + c * 2) = (bf16)f2bf(wr[e]); *(bf16*)(WT + 9216 + d * 144 + c * 2) = (bf16)f2bf(wi[e]); }
        if (tid < 64) {
            const float lamv = PP(rglru_lam)[l * D_A + c0 + tid];
            SP[tid] = log1pf(expf(-lamv));
            BR[tid] = PP(gate_r_b)[(l * 16 + n) * 64 + tid]; BI[tid] = PP(gate_i_b)[(l * 16 + n) * 64 + tid];
            HC[tid] = SAMPLE ? PP(state_rglru)[((size_t)l * NBATCH + b) * D_A + c0 + tid] : 0.f;
        }
        if (tid < 320) { const int j = tid >> 6, d = tid & 63; CW[tid] = (j < 4) ? PP(conv_w)[((size_t)l * 4 + j) * D_A + c0 + d] : PP(conv_b)[l * D_A + c0 + d]; }
    }
    const int tq = tid >> 3, cg8 = tid & 7;
    const int nchunks = (T + 127) >> 7;
    const bf16* xa_base = PROJ + (size_t)rowbase * IN_COLS + C_XA + c0;
    const bf16* ga_base = PROJ + (size_t)rowbase * IN_COLS + C_GA + c0 + 8 * cg8;
    u32x4 pxa[3], pga[2];
#define RG_FETCH(ck_) do { \
        _Pragma("unroll") for (int k = 0; k < 3; ++k) { const int id = tid + 512 * k, i = id >> 3, cg = id & 7, tk = (ck_) * 128 - 3 + i; \
            pxa[k] = (u32x4){0u, 0u, 0u, 0u}; \
            if (id < 131 * 8 && tk >= 0 && tk < T) pxa[k] = *(const u32x4*)(xa_base + (size_t)tk * IN_COLS + 8 * cg); } \
        _Pragma("unroll") for (int k = 0; k < 2; ++k) { const int tk = (ck_) * 128 + tq + 64 * k; pga[k] = (u32x4){0u, 0u, 0u, 0u}; \
            if (tk < T) pga[k] = *(const u32x4*)(ga_base + (size_t)tk * IN_COLS); } \
    } while (0)
    RG_FETCH(0);
    for (int ck = 0; ck < nchunks; ++ck) {
        const int t0 = ck * 128;
#pragma unroll
        for (int k = 0; k < 3; ++k) {
            const int id = tid + 512 * k, i = id >> 3, cg = id & 7, tk = t0 - 3 + i;
            if (id < 131 * 8) {
                u32x4 raw = pxa[k];
                if (SAMPLE && tk < 0) { const float* sc = PP(state_conv) + (((size_t)l * NBATCH + b) * 3 + (3 + tk)) * D_A + c0 + 8 * cg; const f32x4 lo = *(const f32x4*)sc, hi = *(const f32x4*)(sc + 4);
                    raw.x = pk2(lo[0], lo[1]); raw.y = pk2(lo[2], lo[3]); raw.z = pk2(hi[0], hi[1]); raw.w = pk2(hi[2], hi[3]); }
                *(u32x4*)(XAB + i * 128 + cg * 16) = raw;
            }
        }
        const u32x4 ga0 = pga[0], ga1 = pga[1];
        if (ck + 1 < nchunks) RG_FETCH(ck + 1);
        LDS_BARRIER();
#pragma unroll
        for (int k = 0; k < 2; ++k) {
            const int t = tq + 64 * k;
            float xc[8];
            { const f32x4 c0v = *(const f32x4*)(CW + 256 + 8 * cg8), c1v = *(const f32x4*)(CW + 256 + 8 * cg8 + 4);
#pragma unroll
              for (int e = 0; e < 4; ++e) { xc[e] = c0v[e]; xc[4 + e] = c1v[e]; } }
#pragma unroll
            for (int j = 0; j < 4; ++j) {
                const u32x4 raw = *(const u32x4*)(XAB + (t + j) * 128 + cg8 * 16);
                const f32x4 w0 = *(const f32x4*)(CW + j * 64 + 8 * cg8), w1 = *(const f32x4*)(CW + j * 64 + 8 * cg8 + 4);
                xc[0] += w0[0] * bflo(raw.x); xc[1] += w0[1] * bfhi(raw.x); xc[2] += w0[2] * bflo(raw.y); xc[3] += w0[3] * bfhi(raw.y);
                xc[4] += w1[0] * bflo(raw.z); xc[5] += w1[1] * bfhi(raw.z); xc[6] += w1[2] * bflo(raw.w); xc[7] += w1[3] * bfhi(raw.w);
            }
            u32x4 o; o.x = pk2(xc[0], xc[1]); o.y = pk2(xc[2], xc[3]); o.z = pk2(xc[4], xc[5]); o.w = pk2(xc[6], xc[7]);
            *(u32x4*)(XCB + t * 144 + cg8 * 16) = o;
        }
        LDS_BARRIER();
        {
            const bf16x8 a0 = *(const bf16x8*)(XCB + (16 * w + c16) * 144 + 16 * g), a1 = *(const bf16x8*)(XCB + (16 * w + c16) * 144 + 64 + 16 * g);
#pragma unroll
            for (int db = 0; db < 4; ++db) {
                const unsigned char* wp = WT + (16 * db + c16) * 144 + 16 * g;
                const bf16x8 r0 = *(const bf16x8*)wp, r1 = *(const bf16x8*)(wp + 64), i0 = *(const bf16x8*)(wp + 9216), i1 = *(const bf16x8*)(wp + 9216 + 64);
                f32x4 ar = {0.f, 0.f, 0.f, 0.f}, ai = {0.f, 0.f, 0.f, 0.f};
                ar = MFMA16(a0, r0, ar); ar = MFMA16(a1, r1, ar); ai = MFMA16(a0, i0, ai); ai = MFMA16(a1, i1, ai);
                const int d = 16 * db + c16;
                const float brv = BR[d], biv = BI[d], spv = SP[d];
#pragma unroll
                for (int r = 0; r < 4; ++r) {
                    const int t = 16 * w + 4 * g + r;
                    const float xcv = bflo((unsigned)*(const bf16*)(XCB + t * 144 + d * 2));
                    const float la = -8.0f * sigmoidf_(ar[r] + brv) * spv;
                    const float a = __expf(la), t2 = 2.0f * la;
                    const float ser = -t2 * (1.0f + t2 * 0.5f * (1.0f + t2 * (1.0f / 3.0f) * (1.0f + t2 * 0.25f * (1.0f + t2 * 0.2f))));
                    const float om = (t2 > -0.125f) ? ser : (1.0f - a * a);
                    const float bb = __builtin_amdgcn_sqrtf(om) * (sigmoidf_(ai[r] + biv) * xcv);
                    const bool valid = (t0 + t) < T;
                    AL[t * 64 + d] = valid ? a : 1.f; BL[t * 64 + d] = valid ? bb : 0.f;
                }
            }
        }
        LDS_BARRIER();
        {
            float cum = 1.f, hl = 0.f;
#pragma unroll
            for (int i = 0; i < 16; ++i) { const int ix = (16 * w + i) * 64 + lane; const float a = AL[ix], bb = BL[ix]; hl = a * hl + bb; cum *= a; AL[ix] = cum; BL[ix] = hl; }
            SA[w * 64 + lane] = cum; SH[w * 64 + lane] = hl;
        }
        LDS_BARRIER();
        {
            float hin = HC[(ck & 1) * 64 + lane];
#pragma unroll
            for (int ww = 0; ww < 7; ++ww) { const float sa = SA[ww * 64 + lane], sh = SH[ww * 64 + lane]; if (ww < w) hin = sa * hin + sh; }
            float h = hin;
#pragma unroll
            for (int i = 0; i < 16; ++i) { const int ix = (16 * w + i) * 64 + lane; h = AL[ix] * hin + BL[ix]; BL[ix] = h; }
            if (w == 7) HC[((ck + 1) & 1) * 64 + lane] = h;
        }
        LDS_BARRIER();
#pragma unroll
        for (int k = 0; k < 2; ++k) {
            const int t = tq + 64 * k;
            if (t0 + t < T) {
                const size_t row = (size_t)(rowbase + t0 + t);
                const u32x4 raw = k ? ga1 : ga0;
                const f32x4 h0 = *(const f32x4*)(BL + t * 64 + 8 * cg8), h1 = *(const f32x4*)(BL + t * 64 + 8 * cg8 + 4);
                u32x4 o;
                o.x = pk2(h0[0] * siluf_(bflo(raw.x)), h0[1] * siluf_(bfhi(raw.x))); o.y = pk2(h0[2] * siluf_(bflo(raw.y)), h0[3] * siluf_(bfhi(raw.y)));
                o.z = pk2(h1[0] * siluf_(bflo(raw.z)), h1[1] * siluf_(bfhi(raw.z))); o.w = pk2(h1[2] * siluf_(bflo(raw.w)), h1[3] * siluf_(bfhi(raw.w)));
                *(u32x4*)(YAB + row * D_MODEL + c0 + 8 * cg8) = o;
            }
        }
    }
#undef RG_FETCH
    float* o_r = P_OUT + (SAMPLE ? O_RS : O_RP) + ((size_t)l * NBATCH + b) * D_A + c0;
    float* o_c = P_OUT + (SAMPLE ? O_CS : O_CP) + ((size_t)l * NBATCH + b) * 3 * D_A + c0;
    if (tid < 64) o_r[tid] = HC[(nchunks & 1) * 64 + tid];
    if (tid < 192) { const int i = tid >> 6, d = tid & 63; o_c[(size_t)i * D_A + d] = bflo((unsigned)PROJ[(size_t)(rowbase + T - 3 + i) * IN_COLS + C_XA + c0 + d]); }
}

constexpr int AT_K = 0, AT_KB = 17408, AT_V = 34816, AT_VB = 18432, AT_BT = 71680;
__device__ __forceinline__ void attn_unit(int l, int b, int h, int j, unsigned char* lds) {
    const int tid = opaque_tid(), lane = tid & 63, w = __builtin_amdgcn_readfirstlane(tid >> 6), c16 = lane & 15, g = lane >> 4;
    const bool SAMPLE = (j == -2);
    const bf16* PROJ = (const bf16*)(P_WS + WS_PROJ); bf16* YAB = (bf16*)(P_WS + WS_YAB);
    float* BT = (float*)(lds + AT_BT);
    const float lam = ((const float*)(P_WS + WS_LAM))[l];
    const float lam_init = 0.8f - 0.6f * expf(-0.3f * (float)l);
    int ntiles, nkeys_w, qpos, qrow;
    if (SAMPLE) { ntiles = 33; nkeys_w = (w < 2) ? (PAST + DEC_T) : 0; qpos = PAST + 16 * w + c16; qrow = MP + b * DEC_T + 16 * w + c16; }
    else if (j >= 0) { ntiles = 2 * j + 3; nkeys_w = 80 + 64 * (2 * j + (w >> 2)); qpos = NMETA + 128 * j + 16 * w + c16; qrow = b * LP + qpos; }
    else { ntiles = 1; nkeys_w = (w == 0) ? NMETA : 0; qpos = 16 * w + c16; qrow = b * LP + qpos; }
    const int ntw = (nkeys_w + 63) >> 6;
    bf16x8 qf[2][2];
    {
        const bf16* qp = PROJ + (size_t)qrow * IN_COLS + C_Q + h * 128 + 8 * g;
#pragma unroll
        for (int mp = 0; mp < 2; ++mp)
#pragma unroll
            for (int ks = 0; ks < 2; ++ks) qf[mp][ks] = *(const bf16x8*)(qp + mp * 64 + ks * 32);
    }
    for (int i = tid; i < BT_LDS; i += NTHREADS) BT[i] = (i < BT_N) ? ((const float*)(P_WS + WS_BT))[h * BT_N + i] : 0.f;
    u32x4 skA[2], svA[2], skB[2], svB[2];
    const int sr0 = tid >> 4, sch = tid & 15;
    const float* CKF = PP(cache_k) + (((size_t)l * NBATCH + b) * PAST) * 1024 + h * 128 + sch * 8;
    const float* CVF = PP(cache_v) + (((size_t)l * NBATCH + b) * PAST) * 1024 + h * 128 + sch * 8;
#define AT_LOAD(t, SK, SV) do { \
        _Pragma("unroll") for (int i = 0; i < 2; ++i) { const int r = sr0 + 32 * i; \
            { int krow; \
                if (SAMPLE) { const int rr = r < DEC_T ? r : DEC_T - 1; krow = MP + b * DEC_T + rr; } \
                else { int kp_ = 64 * (t) + r; kp_ = kp_ < LP ? kp_ : LP - 1; krow = b * LP + kp_; } \
                const bf16* src = PROJ + (size_t)krow * IN_COLS + h * 128 + sch * 8; \
                SK[i] = *(const u32x4*)(src + C_K); SV[i] = *(const u32x4*)(src + C_V); } \
        } } while (0)
#define AT_STORE(t, buf, vbuf, SK, SV) do { \
        _Pragma("unroll") for (int i = 0; i < 2; ++i) { const int r = sr0 + 32 * i; \
            *(u32x4*)(lds + AT_K + (buf) * AT_KB + r * 272 + sch * 16) = SK[i]; *(u32x4*)(lds + AT_V + (vbuf) * AT_VB + r * 288 + sch * 16) = SV[i]; \
        } } while (0)
float mrun[2]; f32x4 lacc[2];
    f32x4 O[2][8];
#if DUP_LOOP
    for (int rep_ = 0; rep_ < 2; ++rep_) {
    if (rep_) __syncthreads();
#endif
#pragma unroll
    for (int mp = 0; mp < 2; ++mp)
#pragma unroll
        for (int blk = 0; blk < 8; ++blk) O[mp][blk] = (f32x4){0.f, 0.f, 0.f, 0.f};
    mrun[0] = mrun[1] = 0.f; lacc[0] = lacc[1] = (f32x4){0.f, 0.f, 0.f, 0.f};
    const float SC = 0.125f * LOG2E;
    f32x4 s[2][4]; bf16x8 pf[2][2];
    const unsigned char* vrd = lds + AT_V + (4 * g + (c16 >> 2)) * 288 + (c16 & 3) * 8;
#define AT_PVSTEP(vb_, PF, st, blk) do { \
        const s16x4 lo_ = vtr((vb_) + (32 * (st)) * 288 + (blk) * 32), hi_ = vtr((vb_) + (32 * (st) + 16) * 288 + (blk) * 32); \
        const bf16x8 vf_ = __builtin_shufflevector(lo_, hi_, 0, 1, 2, 3, 4, 5, 6, 7); \
        O[0][blk] = MFMA16(vf_, PF[0][st], O[0][blk]); O[1][blk] = MFMA16(vf_, PF[1][st], O[1][blk]); } while (0)
#define AT_EXPSTEP(mp, kb) do { f32x4 e_; \
        _Pragma("unroll") for (int r = 0; r < 4; ++r) e_[r] = __builtin_amdgcn_exp2f(s[mp][kb][r] - mrun[mp]); \
        if (DUP_EXP) { f32x4 d_; _Pragma("unroll") for (int r = 0; r < 4; ++r) d_[r] = __builtin_amdgcn_exp2f(s[mp][kb][r] - mrun[mp] - 1.0f); lacc[mp] = lacc[mp] + d_ * 0.f; } \
        s[mp][kb] = e_; lacc[mp] = lacc[mp] + e_; } while (0)
#define AT_PACK(PF) do { _Pragma("unroll") for (int mp = 0; mp < 2; ++mp) _Pragma("unroll") for (int st = 0; st < 2; ++st) { \
        u32x4 pk_; pk_.x = pk2(s[mp][2 * st][0], s[mp][2 * st][1]); pk_.y = pk2(s[mp][2 * st][2], s[mp][2 * st][3]); \
        pk_.z = pk2(s[mp][2 * st + 1][0], s[mp][2 * st + 1][1]); pk_.w = pk2(s[mp][2 * st + 1][2], s[mp][2 * st + 1][3]); \
        PF[mp][st] = __builtin_bit_cast(bf16x8, pk_); } } while (0)
#define AT_COMPUTE(t) do { \
        if (t < ntw) { \
            const unsigned char* kb_ = lds + AT_K + (t & 1) * AT_KB + c16 * 272 + 16 * g; \
            const unsigned char* vb_ = vrd + (t & 1) * AT_VB; \
            const int kbase = 64 * t + 4 * g; \
            const bool need_mask = (64 * t + 64 > nkeys_w); \
_Pragma("unroll") \
            for (int kb = 0; kb < 4; ++kb) { \
                bf16x8 kf[2][2]; \
_Pragma("unroll") \
                for (int mp = 0; mp < 2; ++mp) \
_Pragma("unroll") \
                    for (int ks = 0; ks < 2; ++ks) kf[mp][ks] = *(const bf16x8*)(kb_ + kb * (16 * 272) + mp * 128 + ks * 64); \
_Pragma("unroll") \
                for (int mp = 0; mp < 2; ++mp) { \
                    f32x4 a = {0.f, 0.f, 0.f, 0.f}; \
_Pragma("unroll") \
                    for (int ks = 0; ks < 2; ++ks) a = MFMA16(kf[mp][ks], qf[mp][ks], a); \
                    s[mp][kb] = a; \
                } \
                __builtin_amdgcn_sched_barrier(0); \
            } \
_Pragma("unroll") \
            for (int kb = 0; kb < 4; ++kb) { \
                const float* bp_ = BT + (kbase + 16 * kb - qpos + BT_OFF); \
                const f32x4 b4_ = (f32x4){bp_[0], bp_[1], bp_[2], bp_[3]}; \
                s[0][kb] = s[0][kb] * SC + b4_; s[1][kb] = s[1][kb] * SC + b4_; \
            } \
            if (need_mask) { \
_Pragma("unroll") \
                for (int mp = 0; mp < 2; ++mp) \
_Pragma("unroll") \
                    for (int kb = 0; kb < 4; ++kb) \
_Pragma("unroll") \
                        for (int r = 0; r < 4; ++r) if (kbase + 16 * kb + r >= nkeys_w) s[mp][kb][r] = -1e30f; \
            } \
            if (t == 0) { \
_Pragma("unroll") \
                for (int mp = 0; mp < 2; ++mp) { \
                    float mx = -1e30f; \
_Pragma("unroll") \
                    for (int kb = 0; kb < 4; ++kb) mx = fmaxf(fmaxf(mx, fmaxf(s[mp][kb][0], s[mp][kb][1])), fmaxf(s[mp][kb][2], s[mp][kb][3])); \
                    mx = fmaxf(mx, __shfl_xor(mx, 16)); mx = fmaxf(mx, __shfl_xor(mx, 32)); \
                    mrun[mp] = mx; \
                } \
            } \
_Pragma("unroll") \
            for (int mp = 0; mp < 2; ++mp) \
_Pragma("unroll") \
                for (int kb = 0; kb < 4; ++kb) AT_EXPSTEP(mp, kb); \
            AT_PACK(pf); \
_Pragma("unroll") \
            for (int st = 0; st < 2; ++st) \
_Pragma("unroll") \
                for (int blk = 0; blk < 8; ++blk) AT_PVSTEP(vb_, pf, st, blk); \
        } \
    } while (0)
#define AT_ITER(t, FARK, FARV, NEARK, NEARV) do { \
        { const int tf_ = ((t) + 2 < ntiles) ? (t) + 2 : ntiles - 1; AT_LOAD(tf_, FARK, FARV); }     \
        AT_COMPUTE((t)); \
        if ((t) + 1 < ntiles) AT_STORE((t) + 1, ((t) + 1) & 1, ((t) + 1) & 1, NEARK, NEARV); \
        LDS_BARRIER(); } while (0)
    if (!SAMPLE) {
        AT_LOAD(0, skB, svB); AT_STORE(0, 0, 0, skB, svB);
        { const int t1_ = (1 < ntiles) ? 1 : 0; AT_LOAD(t1_, skA, svA); }
        LDS_BARRIER();
        for (int t = 0; t < ntiles; t += 2) {
            AT_ITER(t, skB, svB, skA, svA);
            if (t + 1 < ntiles) AT_ITER(t + 1, skA, svA, skB, svB);
        }
    } else {
        f32x4 fkA[2][2], fvA[2][2], fkB[2][2], fvB[2][2];
#define AT_LOADF(t, FK, FV) do { _Pragma("unroll") for (int i = 0; i < 2; ++i) { const size_t off = (size_t)(64 * (t) + sr0 + 32 * i) * 1024; \
            FK[i][0] = *(const f32x4*)(CKF + off); FK[i][1] = *(const f32x4*)(CKF + off + 4); FV[i][0] = *(const f32x4*)(CVF + off); FV[i][1] = *(const f32x4*)(CVF + off + 4); } } while (0)
#define AT_STOREF(buf, FK, FV) do { _Pragma("unroll") for (int i = 0; i < 2; ++i) { const int r = sr0 + 32 * i; u32x4 ck_, cv_; \
            ck_.x = pk2(FK[i][0][0], FK[i][0][1]); ck_.y = pk2(FK[i][0][2], FK[i][0][3]); ck_.z = pk2(FK[i][1][0], FK[i][1][1]); ck_.w = pk2(FK[i][1][2], FK[i][1][3]); \
            cv_.x = pk2(FV[i][0][0], FV[i][0][1]); cv_.y = pk2(FV[i][0][2], FV[i][0][3]); cv_.z = pk2(FV[i][1][0], FV[i][1][1]); cv_.w = pk2(FV[i][1][2], FV[i][1][3]); \
            *(u32x4*)(lds + AT_K + (buf) * AT_KB + r * 272 + sch * 16) = ck_; *(u32x4*)(lds + AT_V + (buf) * AT_VB + r * 288 + sch * 16) = cv_; } } while (0)
        AT_LOADF(0, fkB, fvB); AT_STOREF(0, fkB, fvB);
        AT_LOADF(1, fkA, fvA);
        LDS_BARRIER();
#pragma nounroll
        for (int t = 0; t < 30; t += 2) {
            AT_LOADF(t + 2, fkB, fvB); AT_COMPUTE(t);     AT_STOREF(1, fkA, fvA); LDS_BARRIER();
            AT_LOADF(t + 3, fkA, fvA); AT_COMPUTE((t + 1)); AT_STOREF(0, fkB, fvB); LDS_BARRIER();
        }
        {
            const int t30 = 30;
#pragma unroll
            for (int i = 0; i < 2; ++i) { const int r = sr0 + 32 * i, rr = r < DEC_T ? r : DEC_T - 1; const bf16* src = PROJ + (size_t)(MP + b * DEC_T + rr) * IN_COLS + h * 128 + sch * 8;
                fkB[i][0] = __builtin_bit_cast(f32x4, *(const u32x4*)(src + C_K)); fkB[i][1] = __builtin_bit_cast(f32x4, *(const u32x4*)(src + C_V)); }
            AT_COMPUTE(t30); AT_STOREF(1, fkA, fvA); LDS_BARRIER();
        }
        {
            const int t31 = 31; AT_COMPUTE(t31);
#pragma unroll
            for (int i = 0; i < 2; ++i) { const int r = sr0 + 32 * i;
                *(u32x4*)(lds + AT_K + r * 272 + sch * 16) = __builtin_bit_cast(u32x4, fkB[i][0]); *(u32x4*)(lds + AT_V + r * 288 + sch * 16) = __builtin_bit_cast(u32x4, fkB[i][1]); }
            LDS_BARRIER();
        }
        { const int t32 = 32; AT_COMPUTE(t32); }
#undef AT_LOADF
#undef AT_STOREF
    }
#undef AT_ITER
#undef AT_COMPUTE
#undef AT_PVSTEP
#undef AT_EXPSTEP
#undef AT_PACK
#undef AT_LOAD
#undef AT_STORE
    if (nkeys_w > 0) {
        float l0 = (lacc[0][0] + lacc[0][1]) + (lacc[0][2] + lacc[0][3]), l1 = (lacc[1][0] + lacc[1][1]) + (lacc[1][2] + lacc[1][3]);
        l0 += __shfl_xor(l0, 16); l0 += __shfl_xor(l0, 32); l1 += __shfl_xor(l1, 16); l1 += __shfl_xor(l1, 32);
        const float inv1 = 1.f / l0, inv2 = lam / l1;
        float ss = 0.f;
#pragma unroll
        for (int blk = 0; blk < 8; ++blk)
#pragma unroll
            for (int r = 0; r < 4; ++r) { const float o = O[0][blk][r] * inv1 - O[1][blk][r] * inv2; O[0][blk][r] = o; ss += o * o; }
        ss += __shfl_xor(ss, 16); ss += __shfl_xor(ss, 32);
        const float rn = rsqrtf(ss * (1.f / 128.f) + EPS) * (1.f - lam_init);
        const bf16* gbp = PROJ + (size_t)qrow * IN_COLS + C_GB + h * 128 + 4 * g;
        const float* sg = PP(subln_g) + l * 128 + 4 * g;
        bf16* yo = YAB + (size_t)qrow * D_MODEL + D_A + h * 128 + 4 * g;
#pragma unroll
        for (int blk = 0; blk < 8; ++blk) {
            const u32x2 gr = *(const u32x2*)(gbp + 16 * blk); const f32x4 sgv = *(const f32x4*)(sg + 16 * blk);
            u32x2 o;
            o.x = pk2(O[0][blk][0] * rn * sgv[0] * siluf_(bflo(gr.x)), O[0][blk][1] * rn * sgv[1] * siluf_(bfhi(gr.x)));
            o.y = pk2(O[0][blk][2] * rn * sgv[2] * siluf_(bflo(gr.y)), O[0][blk][3] * rn * sgv[3] * siluf_(bfhi(gr.y)));
            *(u32x2*)(yo + 16 * blk) = o;
        }
    }
}

constexpr int Q_UNITS = 176;
constexpr int CW_TAIL = 512, TAIL_TILES = 48;
__device__ __forceinline__ void tail_signal(unsigned char* lds, int l) {
    asm volatile("s_waitcnt vmcnt(0)" ::: "memory");
    __syncthreads();
    if (threadIdx.x == 0) {
        __builtin_amdgcn_fence(__ATOMIC_RELEASE, "agent");
        asm volatile("s_waitcnt vmcnt(0)" ::: "memory");
        (void)__hip_atomic_fetch_add((unsigned*)(P_WS + WS_CTL) + CW_TAIL + 64 * l, 1u, __ATOMIC_RELAXED, __HIP_MEMORY_SCOPE_AGENT);
    }
}
__device__ __forceinline__ void tail_wait(unsigned char* lds, int l) {
    if (threadIdx.x == 0) {
        unsigned* p = (unsigned*)(P_WS + WS_CTL) + CW_TAIL + 64 * l;
        const unsigned need = gridDim.x < (unsigned)TAIL_TILES ? gridDim.x : (unsigned)TAIL_TILES;
        unsigned sp = 0u;
        while (__hip_atomic_load(p, __ATOMIC_RELAXED, __HIP_MEMORY_SCOPE_AGENT) < need) { __builtin_amdgcn_s_sleep(2); if (++sp > (1u << 22)) break; }
        __builtin_amdgcn_fence(__ATOMIC_ACQUIRE, "agent");
        asm volatile("s_waitcnt vmcnt(0)" ::: "memory");
    }
    __syncthreads();
}
__device__ __forceinline__ void p2_mixers(int l, unsigned char* lds, int rep = 0) {
    unsigned* ctr = (unsigned*)(P_WS + WS_CTL) + l * 8 + rep * 64;
    volatile int* slot = (volatile int*)(lds + LDS_SLOT);
    const int tid = opaque_tid();
    bool tail_ok = false;
    for (int qq = 0; qq < 8; ++qq) {
        const int b = (blockIdx.x + qq) & 7;
        for (;;) {
            __syncthreads();
            if (tid == 0) *slot = (int)atomicAdd(ctr + b, 1u);
            __syncthreads();
            const int u = __builtin_amdgcn_readfirstlane(*slot);
            if (u >= Q_UNITS) break;
            const int blk8 = u >> 3, idx = u & 7;
            int type, n = 0, j = 0;
            if (blk8 >= 20) { type = 2; n = u - 160; }
            else if (blk8 == 19) { type = 1; j = -1; }
            else if (b != 7) {
                if (blk8 < 2) { type = 0; n = u; }
                else if (blk8 == 2) { type = 1; j = 15; } else if (blk8 == 3) { type = 1; j = 14; } else if (blk8 == 4) { type = 1; j = -2; }
                else { type = 1; j = 18 - blk8; }
            } else {
                if (blk8 < 3) { type = 1; j = 14 - blk8; }
                else if (blk8 < 5) { type = 0; n = u - 24; }
                else if (blk8 == 5) { type = 1; j = 15; } else if (blk8 == 6) { type = 1; j = -2; }
                else { type = 1; j = 18 - blk8; }
            }
            const bool dep = (type == 2) || (type == 1 && j == -2) || (b == 7 && (type == 0 || (type == 1 && j == 15)));
            if (dep && !tail_ok) { tail_wait(lds, l); tail_ok = true; }
            if (type != 1) rglru_unit(l, b, n, type == 2, lds);
            else attn_unit(l, b, idx, j, lds);
        }
    }
}

#define XB_TMO      128
#define XB_XCNT(j)  (256  + 64 * (j))
#define XB_XSUB(j)  (1280 + 64 * (j))
#define XB_XGEN(j)  (2304 + 64 * (j))
#define XB_TOP      3328
#define XB_TOPGEN   3392
#define XCD_BAR_WORDS 3456
#define XB_SPIN_CAP (1u << 18)

__device__ __forceinline__ unsigned xb_ld(unsigned* p)              { return __hip_atomic_load(p, __ATOMIC_RELAXED, __HIP_MEMORY_SCOPE_AGENT); }
__device__ __forceinline__ unsigned xb_add(unsigned* p, unsigned v) { return __hip_atomic_fetch_add(p, v, __ATOMIC_RELAXED, __HIP_MEMORY_SCOPE_AGENT); }
__device__ __forceinline__ unsigned xb_xcc_id() { return (unsigned)__builtin_amdgcn_s_getreg((3 << 11) | 20) & 0xFu; }
#define XB_SPIN(cond, bar) do { unsigned _sp = 0; while (cond) { __builtin_amdgcn_s_sleep(1); \
    if ((++_sp & 255u) == 0u) { if (xb_ld(&(bar)[XB_TMO])) break; if (_sp > XB_SPIN_CAP) { atomicAdd(&(bar)[XB_TMO], 1u); break; } } } } while (0)

struct XcdBarrier {
    unsigned* bar; unsigned x;
    volatile LAS unsigned* st;
};

__device__ __forceinline__ XcdBarrier xcd_barrier_post(unsigned* bar, volatile LAS unsigned* st) {
    XcdBarrier b; b.bar = bar; b.x = xb_xcc_id(); b.st = st;
    if (threadIdx.x == 0) (void)xb_add(&bar[XB_XCNT(b.x)], 1u);
    return b;
}
__device__ __forceinline__ void xcd_barrier_complete(unsigned* bar, unsigned x, unsigned& nloc, unsigned& nx) {
    const unsigned G = gridDim.x * gridDim.y * gridDim.z;
    unsigned sum, cnt, mine, sp = 0u;
    for (;;) {
        sum = 0u; cnt = 0u; mine = 0u;
#pragma unroll
        for (unsigned j = 0; j < 16; ++j) { const unsigned c = xb_ld(&bar[XB_XCNT(j)]); sum += c; cnt += (c > 0u) ? 1u : 0u; mine = (j == x) ? c : mine; }
        if (sum == G) break;
        __builtin_amdgcn_s_sleep(1);
        if ((++sp & 255u) == 0u) { if (xb_ld(&bar[XB_TMO])) break; if (sp > XB_SPIN_CAP) { atomicAdd(&bar[XB_TMO], 1u); break; } }
    }
    nloc = mine > 0u ? mine : 1u; nx = cnt > 0u ? cnt : 1u;
}

__device__ __forceinline__ void xcd_barrier(const XcdBarrier& b) {
    asm volatile("s_waitcnt vmcnt(0)" ::: "memory");
    __syncthreads();
    if (threadIdx.x == 0) {
        unsigned* bar = b.bar;
        __builtin_amdgcn_s_waitcnt(0);
        unsigned nloc = b.st[0], nx = b.st[1];
        if (nloc == 0u) { xcd_barrier_complete(bar, b.x, nloc, nx); b.st[0] = nloc; b.st[1] = nx; }
        const unsigned old = xb_add(&bar[XB_XSUB(b.x)], 1u);
        const unsigned gen = old / nloc;
        if (old + 1u == (gen + 1u) * nloc) {
            __builtin_amdgcn_fence(__ATOMIC_RELEASE, "agent");
            asm volatile("s_waitcnt vmcnt(0)" ::: "memory");
            const unsigned og = xb_add(&bar[XB_TOP], 1u);
            const unsigned tg = og / nx;
            if (og + 1u == (tg + 1u) * nx) xb_add(&bar[XB_TOPGEN], 1u);
            else XB_SPIN(xb_ld(&bar[XB_TOPGEN]) == tg, bar);
            __builtin_amdgcn_fence(__ATOMIC_ACQUIRE, "agent");
            xb_add(&bar[XB_XGEN(b.x)], 1u);
            asm volatile("s_waitcnt vmcnt(0)" ::: "memory");
        } else {
            XB_SPIN(xb_ld(&bar[XB_XGEN(b.x)]) == gen, bar);
            __builtin_amdgcn_fence(__ATOMIC_ACQUIRE, "agent");
            asm volatile("s_waitcnt vmcnt(0)" ::: "memory");
        }
    }
    __syncthreads();
}

__global__ void __launch_bounds__(NTHREADS) hymba_fwd(Params p) {
    extern __shared__ __attribute__((aligned(16))) unsigned char lds[];
    cg::grid_group grid = cg::this_grid();
    if (threadIdx.x == 0) {
        volatile LAS unsigned long long* q = (volatile LAS unsigned long long*)(lds + LDS_PARAM);
        q[0] = (unsigned long long)p.x_prompt; q[1] = (unsigned long long)p.x_sample; q[2] = (unsigned long long)p.cache_k; q[3] = (unsigned long long)p.cache_v;
        q[4] = (unsigned long long)p.state_conv; q[5] = (unsigned long long)p.state_rglru; q[6] = (unsigned long long)p.meta; q[7] = (unsigned long long)p.rel_bias;
        q[8] = (unsigned long long)p.pre_g; q[9] = (unsigned long long)p.post_g; q[10] = (unsigned long long)p.w_in; q[11] = (unsigned long long)p.conv_w;
        q[12] = (unsigned long long)p.conv_b; q[13] = (unsigned long long)p.gate_r_w; q[14] = (unsigned long long)p.gate_r_b; q[15] = (unsigned long long)p.gate_i_w;
        q[16] = (unsigned long long)p.gate_i_b; q[17] = (unsigned long long)p.rglru_lam; q[18] = (unsigned long long)p.lam_q1; q[19] = (unsigned long long)p.lam_k1;
        q[20] = (unsigned long long)p.lam_q2; q[21] = (unsigned long long)p.lam_k2; q[22] = (unsigned long long)p.subln_g; q[23] = (unsigned long long)p.w_out;
        q[24] = (unsigned long long)p.out; q[25] = (unsigned long long)p.ws;
    }
    if (threadIdx.x < 2) ((volatile LAS unsigned*)(lds + LDS_SLOT + 16))[threadIdx.x] = 0u;
    __syncthreads();
    (void)xcd_barrier_post((unsigned*)(P_WS + WS_BAR), (volatile LAS unsigned*)(lds + LDS_SLOT + 16));
#define GRID_BAR() do { XcdBarrier xb_; xb_.bar = (unsigned*)(P_WS + WS_BAR); xb_.x = xb_xcc_id(); xb_.st = (volatile LAS unsigned*)(lds + LDS_SLOT + 16); xcd_barrier(xb_); } while (0)
    p0_prologue(lds);
    GRID_BAR();
    if (gridDim.x == 0x7fffffffu) grid.sync();
#if DUP_P0
    p0_prologue(lds);
    grid.sync();
#endif
    for (int l = 0; l < DEPTH; ++l) {
        {
            pg8::Gemm gm{(const pg8::bf16_t*)(P_WS + WS_U), (const pg8::bf16_t*)(P_WS + WS_WIN) + (size_t)l * IN_COLS * D_MODEL, TAIL_ROW0, IN_COLS, D_MODEL, D_MODEL};
            pg8::StaticOrder S; S.init(TAIL_ROW0, IN_COLS, (int)gridDim.x, (int)blockIdx.x);
            EpiProj E{(bf16*)(P_WS + WS_PROJ), P_OUT + O_KP + (size_t)l * MP * 1024, P_OUT + O_VP + (size_t)l * MP * 1024, P_OUT + O_KS + (size_t)l * MS * 1024, P_OUT + O_VS + (size_t)l * MS * 1024};
            pg8::gemm_phase<EpiProj, pg8::StaticOrder, true, true>((PG8_LAS unsigned char*)lds, gm, S, E);
#if DUP_G1
            GRID_BAR();
            pg8::gemm_phase<EpiProj, pg8::StaticOrder, true, true>((PG8_LAS unsigned char*)lds, gm, S, E);
#endif
        }
        GRID_BAR();
        if (blockIdx.x < TAIL_TILES) {
            pg8::Gemm gt{(const pg8::bf16_t*)(P_WS + WS_U), (const pg8::bf16_t*)(P_WS + WS_WIN) + (size_t)l * IN_COLS * D_MODEL, MPAD, IN_COLS, D_MODEL, D_MODEL};
            TailWhole St{(int)gridDim.x, (int)blockIdx.x};
            EpiProj Et{(bf16*)(P_WS + WS_PROJ), P_OUT + O_KP + (size_t)l * MP * 1024, P_OUT + O_VP + (size_t)l * MP * 1024, P_OUT + O_KS + (size_t)l * MS * 1024, P_OUT + O_VS + (size_t)l * MS * 1024};
            pg8::gemm_phase<EpiProj, TailWhole, false, true>((PG8_LAS unsigned char*)lds, gt, St, Et);
            tail_signal(lds, l);
        }
        p2_mixers(l, lds);
        GRID_BAR();
#if DUP_SYNC
        GRID_BAR(); GRID_BAR(); GRID_BAR(); GRID_BAR();
#endif
#if DUP_P2
        p2_mixers(l, lds, 1);
        GRID_BAR();
#endif
        {
            const pg8::bf16_t* Wl = (const pg8::bf16_t*)(P_WS + WS_WOUT) + (size_t)l * D_MODEL * D_MODEL;
            {
                pg8::Gemm gm{(const pg8::bf16_t*)(P_WS + WS_YAB), Wl, TAIL_ROW0, D_MODEL, D_MODEL, D_MODEL};
                pg8::StaticOrder S; S.init(TAIL_ROW0, D_MODEL, (int)gridDim.x, (int)blockIdx.x);
                EpiY16 E{(bf16*)(P_WS + WS_Y)};
                pg8::gemm_phase<EpiY16, pg8::StaticOrder, true, true>((PG8_LAS unsigned char*)lds, gm, S, E);
#if DUP_G2
                pg8::gemm_phase<EpiY16, pg8::StaticOrder, true, true>((PG8_LAS unsigned char*)lds, gm, S, E);
#endif
            }
            {
                pg8::Gemm gm{(const pg8::bf16_t*)(P_WS + WS_YAB), Wl, MPAD, D_MODEL, TAIL_K, D_MODEL};
                TailOrder S{(int)gridDim.x, (int)blockIdx.x};
                EpiPart E{(float*)(P_WS + WS_PART)};
                pg8::gemm_phase<EpiPart, TailOrder, false, true>((PG8_LAS unsigned char*)lds, gm, S, E);
#if DUP_G2
                pg8::gemm_phase<EpiPart, TailOrder, false, true>((PG8_LAS unsigned char*)lds, gm, S, E);
#endif
            }
        }
        GRID_BAR();
#if DUP_P4
        p4_rowpass(lds, l, true);
        GRID_BAR();
#endif
        p4_rowpass(lds, l);
        if (l + 1 < DEPTH) GRID_BAR();
    }
}

extern "C" void kernel_launch(void* const* d_in, const int* in_sizes, int n_in, void* d_out, int out_size, void* d_ws, size_t ws_size, hipStream_t stream) {
    static int grid = 0;
    if (grid == 0) {
        if (n_in != 24 || (size_t)out_size != O_END || ws_size < WS_END) { fprintf(stderr, "kernel_launch: unexpected shapes (n_in %d, out %d, ws %zu)\n", n_in, out_size, ws_size); grid = -1; return; }
        int dev = 0, cus = 0, per_cu = 0;
        if (hipGetDevice(&dev) != hipSuccess || hipDeviceGetAttribute(&cus, hipDeviceAttributeMultiprocessorCount, dev) != hipSuccess) { grid = -1; return; }
        if (hipFuncSetAttribute((const void*)hymba_fwd, hipFuncAttributeMaxDynamicSharedMemorySize, LDS_BYTES) != hipSuccess) { fprintf(stderr, "kernel_launch: hipFuncSetAttribute failed\n"); grid = -1; return; }
        if (hipOccupancyMaxActiveBlocksPerMultiprocessor(&per_cu, (const void*)hymba_fwd, NTHREADS, LDS_BYTES) != hipSuccess || per_cu < 1) { fprintf(stderr, "kernel_launch: occupancy query gives %d\n", per_cu); per_cu = 1; (void)hipGetLastError(); }
        grid = cus * 1;
    }
    if (grid < 0) return;
    (void)hipMemsetAsync((char*)d_ws + WS_CTL, 0, CTL_BYTES, stream);
    Params p{};
    const float** pp = (const float**)&p;
    for (int i = 0; i < 24; ++i) pp[i] = (const float*)d_in[i];
    p.out = (float*)d_out; p.ws = (unsigned char*)d_ws;
    void* args[] = {&p};
    hipError_t e = hipLaunchCooperativeKernel((const void*)hymba_fwd, dim3(grid), dim3(NTHREADS), args, LDS_BYTES, stream);
    if (e != hipSuccess) fprintf(stderr, "cooperative launch failed: %s (grid %d)\n", hipGetErrorString(e), grid);
}
```
